# Optimizing an MI355X kernel written in HIP

```python
import math
import jax, jax.numpy as jnp
from jax import lax
import numpy as np

D_MODEL = 2048
BATCH = 2
SEQ = 16384
DEPTH = 2

N_SSM_LAYERS = DEPTH // 2
N_MLA_LAYERS = DEPTH - N_SSM_LAYERS
MEM_TOKENS = 256
MEM_HEADS = 4
MEM_WIDTH = D_MODEL // 4
MEM_HEAD_DIM = MEM_WIDTH // MEM_HEADS
MAIN_WIDTH = D_MODEL - MEM_WIDTH
SSM_GROUP = 16
SSM_GROUPS = MAIN_WIDTH // SSM_GROUP
SSM_STATE = 64
SSM_CHUNK = 256
DT_MIN, DT_MAX = 0.001, 0.1
MLA_V_DIM = 128
MLA_HEADS = MAIN_WIDTH // MLA_V_DIM
MLA_NOPE = 128
MLA_ROPE = 64
MLA_QK = MLA_NOPE + MLA_ROPE
Q_LORA = D_MODEL // 4
KV_LORA = D_MODEL // 4
ROPE_BASE = 10000.0
ATTN_BLOCK = 128
ALPHA = (2.0 * DEPTH) ** 0.25
BETA = (8.0 * DEPTH) ** -0.25
LN_EPS = 1e-5
RMS_EPS = 1e-6
NEG_INF = -1e30

W_IN_A_COLS = 2 * MAIN_WIDTH + 2 * MEM_WIDTH
W_IN_B_COLS = Q_LORA + MAIN_WIDTH + 2 * MEM_WIDTH

kernel_name = "yoco_s5_mla_memory_deepnorm"


def layer_norm(x, g, b):
    xf = x.astype(jnp.float32)
    mu = jnp.mean(xf, axis=-1, keepdims=True)
    var = jnp.mean(jnp.square(xf - mu), axis=-1, keepdims=True)
    out = (xf - mu) * lax.rsqrt(var + LN_EPS) * g.astype(jnp.float32) + b.astype(jnp.float32)
    return out.astype(x.dtype)


def rms_norm(x, g):
    xf = x.astype(jnp.float32)
    out = xf * lax.rsqrt(jnp.mean(jnp.square(xf), axis=-1, keepdims=True) + RMS_EPS) * g.astype(jnp.float32)
    return out.astype(x.dtype)


def rope_tables(positions):
    inv_freq = ROPE_BASE ** (-jnp.arange(0, MLA_ROPE, 2, dtype=jnp.float32) / MLA_ROPE)
    ang = positions.astype(jnp.float32)[..., None] * inv_freq
    return jnp.cos(ang), jnp.sin(ang)


def apply_rope(x, cos, sin):
    xf = x.astype(jnp.float32)
    x1, x2 = jnp.split(xf, 2, axis=-1)
    out = jnp.concatenate([x1 * cos - x2 * sin, x2 * cos + x1 * sin], axis=-1)
    return out.astype(x.dtype)


def _complex_scan_combine(left, right):
    a1r, a1i, b1r, b1i = left
    a2r, a2i, b2r, b2i = right
    return (a2r * a1r - a2i * a1i,
            a2r * a1i + a2i * a1r,
            a2r * b1r - a2i * b1i + b2r,
            a2r * b1i + a2i * b1r + b2i)


def s5_branch(u, lam_re, lam_im, log_dt, b_re, b_im, c_re, c_im, d_skip, w_glu, b_glu):
    bsz, seq, _ = u.shape
    uf = u.astype(jnp.float32).reshape(bsz, seq, SSM_GROUPS, SSM_GROUP)
    lr = lam_re.astype(jnp.float32)
    li = lam_im.astype(jnp.float32)
    dt = jnp.exp(log_dt.astype(jnp.float32))[:, None]
    mag = jnp.exp(lr * dt)
    a_re = mag * jnp.cos(li * dt)
    a_im = mag * jnp.sin(li * dt)
    den = lr * lr + li * li
    n_re, n_im = a_re - 1.0, a_im
    coef_re = (n_re * lr + n_im * li) / den
    coef_im = (n_im * lr - n_re * li) / den
    br, bi = b_re.astype(jnp.float32), b_im.astype(jnp.float32)
    bb_re = coef_re[..., None] * br - coef_im[..., None] * bi
    bb_im = coef_re[..., None] * bi + coef_im[..., None] * br
    cr, ci = c_re.astype(jnp.float32), c_im.astype(jnp.float32)
    dsk = d_skip.astype(jnp.float32)

    chunk = math.gcd(seq, SSM_CHUNK)
    n_chunks = seq // chunk
    uc = uf.reshape(bsz, n_chunks, chunk, SSM_GROUPS, SSM_GROUP).transpose(1, 0, 2, 3, 4)

    def step(carry, u_blk):
        h_re, h_im = carry
        bu_re = jnp.einsum('blgh,gph->blgp', u_blk, bb_re)
        bu_im = jnp.einsum('blgh,gph->blgp', u_blk, bb_im)
        ar_b = jnp.broadcast_to(a_re, bu_re.shape)
        ai_b = jnp.broadcast_to(a_im, bu_re.shape)
        pa_re, pa_im, s_re, s_im = lax.associative_scan(
            _complex_scan_combine, (ar_b, ai_b, bu_re, bu_im), axis=1)
        x_re = s_re + pa_re * h_re[:, None] - pa_im * h_im[:, None]
        x_im = s_im + pa_re * h_im[:, None] + pa_im * h_re[:, None]
        y = (jnp.einsum('blgp,ghp->blgh', x_re, cr)
             - jnp.einsum('blgp,ghp->blgh', x_im, ci)
             + dsk * u_blk)
        return (x_re[:, -1], x_im[:, -1]), y

    init = (jnp.zeros((bsz, SSM_GROUPS, SSM_STATE), jnp.float32),
            jnp.zeros((bsz, SSM_GROUPS, SSM_STATE), jnp.float32))
    _, ys = lax.scan(step, init, uc)
    y = ys.transpose(1, 0, 2, 3, 4).reshape(bsz, seq, MAIN_WIDTH).astype(u.dtype)
    g = jax.nn.gelu(y)
    return g * jax.nn.sigmoid(g @ w_glu + b_glu)


def causal_block_attention(q, k, v):
    bsz, seq, nh, dk = q.shape
    dv = v.shape[-1]
    nb = seq // ATTN_BLOCK
    scale = dk ** -0.5
    qb = q.reshape(bsz, nb, ATTN_BLOCK, nh, dk).transpose(1, 0, 2, 3, 4)
    offs = jnp.arange(ATTN_BLOCK)

    def one_block(args):
        qi, i = args
        qpos = i * ATTN_BLOCK + offs

        def body(j, carry):
            m, l, acc = carry
            kj = lax.dynamic_slice_in_dim(k, j * ATTN_BLOCK, ATTN_BLOCK, axis=1)
            vj = lax.dynamic_slice_in_dim(v, j * ATTN_BLOCK, ATTN_BLOCK, axis=1)
            s = jnp.einsum('bqhd,bkhd->bhqk', qi, kj,
                           preferred_element_type=jnp.float32) * scale
            kpos = j * ATTN_BLOCK + offs
            s = jnp.where(kpos[None, :] <= qpos[:, None], s, NEG_INF)
            m_new = jnp.maximum(m, jnp.max(s, axis=-1))
            p = jnp.exp(s - m_new[..., None])
            corr = jnp.exp(m - m_new)
            l_new = l * corr + jnp.sum(p, axis=-1)
            acc_new = acc * corr[..., None] + jnp.einsum(
                'bhqk,bkhd->bhqd', p, vj.astype(jnp.float32))
            return m_new, l_new, acc_new

        init = (jnp.full((bsz, nh, ATTN_BLOCK), NEG_INF, jnp.float32),
                jnp.zeros((bsz, nh, ATTN_BLOCK), jnp.float32),
                jnp.zeros((bsz, nh, ATTN_BLOCK, dv), jnp.float32))
        m, l, acc = lax.fori_loop(0, i + 1, body, init)
        return (acc / l[..., None]).transpose(0, 2, 1, 3)

    out = lax.map(one_block, (qb, jnp.arange(nb)))
    return out.transpose(1, 0, 2, 3, 4).reshape(bsz, seq, nh, dv).astype(q.dtype)


def memory_attention(mq, mem, w_mem_kv):
    bsz, seq, _ = mq.shape
    kv = mem @ w_mem_kv
    mk, mv = jnp.split(kv, 2, axis=-1)
    mk = mk.reshape(bsz, -1, MEM_HEADS, MEM_HEAD_DIM)
    mv = mv.reshape(bsz, -1, MEM_HEADS, MEM_HEAD_DIM)
    q = mq.reshape(bsz, seq, MEM_HEADS, MEM_HEAD_DIM)
    s = jnp.einsum('bshd,bmhd->bhsm', q, mk,
                   preferred_element_type=jnp.float32) * (MEM_HEAD_DIM ** -0.5)
    p = jax.nn.softmax(s, axis=-1)
    o = jnp.einsum('bhsm,bmhd->bshd', p, mv.astype(jnp.float32))
    return o.reshape(bsz, seq, MEM_WIDTH).astype(mq.dtype)


def setup_inputs(seed: int = 0) -> dict:
    key = jax.random.key(seed)
    ks = jax.random.split(key, 32)
    f32 = jnp.float32
    nrm = lambda k, shape, std: jax.random.normal(k, shape, f32) * std
    n_idx = jnp.arange(SSM_STATE, dtype=f32)
    lam_re = -0.5 + nrm(ks[3], (N_SSM_LAYERS, SSM_GROUPS, SSM_STATE), 0.01)
    lam_im = math.pi * n_idx + nrm(ks[4], (N_SSM_LAYERS, SSM_GROUPS, SSM_STATE), 0.01)
    log_dt = jax.random.uniform(ks[5], (N_SSM_LAYERS, SSM_GROUPS), f32,
                                math.log(DT_MIN), math.log(DT_MAX))
    return {
        "x": nrm(ks[0], (BATCH, SEQ, D_MODEL), 1.0),
        "mem": nrm(ks[1], (BATCH, MEM_TOKENS, D_MODEL), 1.0),
        "positions": jnp.broadcast_to(jnp.arange(SEQ, dtype=jnp.int32), (BATCH, SEQ)),
        "w_in_a": nrm(ks[2], (N_SSM_LAYERS, D_MODEL, W_IN_A_COLS), D_MODEL ** -0.5),
        "lam_re": lam_re,
        "lam_im": lam_im,
        "log_dt": log_dt,
        "b_re": nrm(ks[6], (N_SSM_LAYERS, SSM_GROUPS, SSM_STATE, SSM_GROUP), (2 * SSM_GROUP) ** -0.5),
        "b_im": nrm(ks[7], (N_SSM_LAYERS, SSM_GROUPS, SSM_STATE, SSM_GROUP), (2 * SSM_GROUP) ** -0.5),
        "c_re": nrm(ks[8], (N_SSM_LAYERS, SSM_GROUPS, SSM_GROUP, SSM_STATE), (2 * SSM_STATE) ** -0.5),
        "c_im": nrm(ks[9], (N_SSM_LAYERS, SSM_GROUPS, SSM_GROUP, SSM_STATE), (2 * SSM_STATE) ** -0.5),
        "d_skip": nrm(ks[10], (N_SSM_LAYERS, SSM_GROUPS, SSM_GROUP), 1.0),
        "w_glu": nrm(ks[11], (N_SSM_LAYERS, MAIN_WIDTH, MAIN_WIDTH), MAIN_WIDTH ** -0.5),
        "b_glu": nrm(ks[12], (N_SSM_LAYERS, MAIN_WIDTH), 0.01),
        "w_in_b": nrm(ks[13], (N_MLA_LAYERS, D_MODEL, W_IN_B_COLS), D_MODEL ** -0.5),
        "q_norm_g": 1.0 + nrm(ks[14], (N_MLA_LAYERS, Q_LORA), 0.02),
        "w_uq": nrm(ks[15], (N_MLA_LAYERS, Q_LORA, MLA_HEADS, MLA_QK), Q_LORA ** -0.5),
        "w_dkv": nrm(ks[16], (D_MODEL, KV_LORA), D_MODEL ** -0.5),
        "kv_norm_g": 1.0 + nrm(ks[17], (KV_LORA,), 0.02),
        "w_kr": nrm(ks[18], (D_MODEL, MLA_ROPE), D_MODEL ** -0.5),
        "w_uk": nrm(ks[19], (KV_LORA, MLA_HEADS, MLA_NOPE), KV_LORA ** -0.5),
        "w_uv": nrm(ks[20], (KV_LORA, MLA_HEADS, MLA_V_DIM), KV_LORA ** -0.5),
        "w_mem_kv": nrm(ks[21], (DEPTH, D_MODEL, 2 * MEM_WIDTH), D_MODEL ** -0.5),
        "w_out": nrm(ks[22], (DEPTH, D_MODEL, D_MODEL), BETA * D_MODEL ** -0.5),
        "ln_g": 1.0 + nrm(ks[23], (DEPTH, D_MODEL), 0.02),
        "ln_b": nrm(ks[24], (DEPTH, D_MODEL), 0.02),
    }


def reference(x, mem, positions, w_in_a, lam_re, lam_im, log_dt, b_re, b_im, c_re, c_im,
              d_skip, w_glu, b_glu, w_in_b, q_norm_g, w_uq, w_dkv, kv_norm_g, w_kr,
              w_uk, w_uv, w_mem_kv, w_out, ln_g, ln_b):
    bsz, seq, _ = x.shape
    cos, sin = rope_tables(positions)
    k_shared = None
    v_shared = None
    for layer in range(DEPTH):
        if layer < N_SSM_LAYERS:
            i = layer
            h = x @ w_in_a[i]
            u, z, mq, mz = jnp.split(
                h, [MAIN_WIDTH, 2 * MAIN_WIDTH, 2 * MAIN_WIDTH + MEM_WIDTH], axis=-1)
            main = s5_branch(u, lam_re[i], lam_im[i], log_dt[i], b_re[i], b_im[i],
                             c_re[i], c_im[i], d_skip[i], w_glu[i], b_glu[i])
        else:
            j = layer - N_SSM_LAYERS
            h = x @ w_in_b[j]
            cq, z, mq, mz = jnp.split(
                h, [Q_LORA, Q_LORA + MAIN_WIDTH, Q_LORA + MAIN_WIDTH + MEM_WIDTH], axis=-1)
            q = jnp.einsum('bsc,chd->bshd', rms_norm(cq, q_norm_g[j]), w_uq[j])
            q_nope, q_rope = jnp.split(q, [MLA_NOPE], axis=-1)
            q_rope = apply_rope(q_rope, cos[:, :, None, :], sin[:, :, None, :])
            q = jnp.concatenate([q_nope, q_rope], axis=-1)
            attn = causal_block_attention(q, k_shared, v_shared)
            main = attn.reshape(bsz, seq, MAIN_WIDTH)
        main = main * jax.nn.silu(z)
        memo = memory_attention(mq, mem, w_mem_kv[layer]) * jax.nn.silu(mz)
        y = jnp.concatenate([main, memo], axis=-1) @ w_out[layer]
        x = layer_norm(ALPHA * x + y, ln_g[layer], ln_b[layer])
        if layer == N_SSM_LAYERS - 1:
            c_kv = rms_norm(x @ w_dkv, kv_norm_g)
            k_rope = apply_rope(x @ w_kr, cos, sin)
            k_nope = jnp.einsum('bsc,chd->bshd', c_kv, w_uk)
            v_shared = jnp.einsum('bsc,chd->bshd', c_kv, w_uv)
            k_shared = jnp.concatenate(
                [k_nope, jnp.broadcast_to(k_rope[:, :, None, :], (bsz, seq, MLA_HEADS, MLA_ROPE))],
                axis=-1)
    return x
```

```cpp
#include <hip/hip_runtime.h>
#include <hip/hip_cooperative_groups.h>
#include <stdint.h>
#include <stdio.h>

namespace cg = cooperative_groups;
namespace {
typedef unsigned short bf16_t;
typedef short bf16x8 __attribute__((ext_vector_type(8)));
typedef float f32x4 __attribute__((ext_vector_type(4)));
typedef float f32x16 __attribute__((ext_vector_type(16)));
typedef unsigned u32x2 __attribute__((ext_vector_type(2)));
typedef unsigned u32x4 __attribute__((ext_vector_type(4)));
typedef int v8i_t __attribute__((ext_vector_type(8)));

constexpr int D_MODEL = 2048, BATCH = 2, SEQ = 16384, T = BATCH * SEQ;
constexpr int MAIN_W = 1536, MEM_W = 512;
constexpr int NA = 4096;
constexpr int NBP = 3584;
constexpr int HB_CQ = 0, HB_Z = 512, HB_MQ = 2048, HB_MZ = 2560, HB_CKV = 3072, WB_KR = 3584;
constexpr int KRS = 64;
constexpr int H_U = 0, H_Z = 1536, H_MQ = 3072, H_MZ = 3584;
constexpr int NKV = 3072;
constexpr int NQ = 2304;
constexpr float ALPHA = 1.4142135623730951f;
constexpr float LN_EPS = 1e-5f, RMS_EPS = 1e-6f;
constexpr float LOG2E = 1.4426950408889634f;
constexpr float C2_MLA = 0.07216878364870322f * LOG2E;
constexpr float C2_MEM = 0.08838834764831845f * LOG2E;

constexpr size_t MiB = 1u << 20;
constexpr size_t WS_WA = 1 * MiB;
constexpr size_t WS_WGLU = 17 * MiB;
constexpr size_t WS_WOUT = 22 * MiB;
constexpr size_t WS_WB = 38 * MiB;
constexpr size_t WS_WUKV = 53 * MiB;
constexpr size_t WS_WUQ = 56 * MiB;
constexpr size_t WS_WMEM = 59 * MiB;
constexpr size_t WS_MEMB = 67 * MiB;
constexpr size_t WS_MEMKV = 69 * MiB;
constexpr size_t WS_ROPE = 71 * MiB;
constexpr size_t WS_RQ = 79 * MiB;
constexpr size_t WS_RKV = 80 * MiB;
constexpr size_t WS_KR = 84 * MiB;
constexpr size_t WS_XB = 96 * MiB;
constexpr size_t WS_H = 224 * MiB;
constexpr size_t WS_G = 480 * MiB;
constexpr size_t WS_CAT = 624 * MiB;
constexpr size_t WS_KV = 752 * MiB;
constexpr size_t WS_END = 944 * MiB;

__device__ __forceinline__ unsigned f2bf(float f) { unsigned u = __float_as_uint(f); return (u + 0x7fffu + ((u >> 16) & 1u)) >> 16; }
__device__ __forceinline__ float bf2f(unsigned b) { return __uint_as_float(b << 16); }
__device__ __forceinline__ unsigned pk2(float lo, float hi) { return f2bf(lo) | (f2bf(hi) << 16); }
__device__ __forceinline__ int crow(int r, int h) { return (r & 3) + 8 * (r >> 2) + 4 * h; }
__device__ __forceinline__ float sigmoidf_(float v) { return __builtin_amdgcn_rcpf(1.f + __builtin_amdgcn_exp2f(-1.4426950408889634f * v)); }
__device__ __forceinline__ float siluf_(float v) { return v * sigmoidf_(v); }
__device__ __forceinline__ float gelu_tanh(float y) { return y * sigmoidf_(1.5957691216057308f * y * (1.f + 0.044715f * y * y)); }
#define MFMA32(a, b, c) __builtin_amdgcn_mfma_f32_32x32x16_bf16((a), (b), (c), 0, 0, 0)


constexpr int NT_ = 512;
constexpr int LDS_BYTES = 147456;
#define LAS __attribute__((address_space(3)))
__device__ __forceinline__ int opaque_tid() { int t = threadIdx.x; asm volatile("" : "+v"(t)); return t; }
__device__ __forceinline__ float shfl_idx(float v, int srclane) { return __int_as_float(__builtin_amdgcn_ds_bpermute(srclane << 2, __float_as_int(v))); }

__device__ __forceinline__ int perm_src(int n, int perm) {
    if (perm == 1) return (n & 1) ? 32 + (n >> 1) : (n >> 1);
    if (perm == 2) { const int j = n % 192; if (j < 128) return n; const int jj = j - 128; return n - j + 128 + ((jj & 1) ? 32 + (jj >> 1) : (jj >> 1)); }
    return n;
}
__device__ __forceinline__ void wt_item_wave(const float* __restrict__ W, int K, int Nsrc, bf16_t* __restrict__ Wt, int row_off, const float* __restrict__ ks, int perm, int item, LAS float* scr, int lane) {
    const int nblk = K / 64, n0 = (item / nblk) * 32, k0 = (item % nblk) * 64;
    const int srcn = perm_src(n0 + (lane & 31), perm);
#pragma unroll 8
    for (int i = 0; i < 32; ++i) { const int kk = 2 * i + (lane >> 5); float v = W[(size_t)(k0 + kk) * Nsrc + srcn]; if (ks) v *= ks[k0 + kk]; scr[kk * 33 + (lane & 31)] = v; }
    asm volatile("s_waitcnt lgkmcnt(0)" ::: "memory"); __builtin_amdgcn_wave_barrier();
    const int c = lane & 7;
#pragma unroll
    for (int j = 0; j < 4; ++j) { const int n = (lane >> 3) + 8 * j; const LAS float* sp = scr + (8 * c) * 33 + n;
        const u32x4 o = {pk2(sp[0], sp[33]), pk2(sp[2 * 33], sp[3 * 33]), pk2(sp[4 * 33], sp[5 * 33]), pk2(sp[6 * 33], sp[7 * 33])};
        *(u32x4*)(Wt + (size_t)(row_off + n0 + n) * K + k0 + 8 * c) = o; }
    asm volatile("s_waitcnt lgkmcnt(0)" ::: "memory"); __builtin_amdgcn_wave_barrier();
}

__device__ __forceinline__ void st_bf16x4(bf16_t* p, f32x4 v) { *(u32x2*)p = (u32x2){pk2(v[0], v[1]), pk2(v[2], v[3])}; }
__device__ __forceinline__ unsigned cvtpk_(float lo, float hi) { typedef float f2_ __attribute__((ext_vector_type(2))); typedef __bf16 b2_ __attribute__((ext_vector_type(2))); const f2_ v = {lo, hi}; const b2_ b = __builtin_convertvector(v, b2_); return __builtin_bit_cast(unsigned, b); }
__device__ __forceinline__ void st_bf16x8(bf16_t* p, f32x4 a, f32x4 b) { *(u32x4*)p = (u32x4){cvtpk_(a[0], a[1]), cvtpk_(a[2], a[3]), cvtpk_(b[0], b[1]), cvtpk_(b[2], b[3])}; }
struct EpiStore {
    bf16_t* O; int ldc; int s_lo, s_hi; float sc;
    __device__ __forceinline__ void apply4(int row, int col, f32x4 v) const { if (col >= s_lo && col < s_hi) v = v * sc; st_bf16x4(O + (size_t)row * ldc + col, v); }
    __device__ __forceinline__ void apply8(int row, int col, f32x4 a, f32x4 b) const { if (col >= s_lo && col < s_hi) { a = a * sc; b = b * sc; } st_bf16x8(O + (size_t)row * ldc + col, a, b); }
};
struct EpiGlu {
    const bf16_t* GZ; const float* bias; bf16_t* CAT;
    __device__ __forceinline__ void apply4(int row, int col, f32x4 v) const {
        const u32x2 gw = *(const u32x2*)(GZ + (size_t)row * MAIN_W + col); const f32x4 bv = *(const f32x4*)(bias + col);
        const float g[4] = {bf2f(gw[0] & 0xffffu), bf2f(gw[0] >> 16), bf2f(gw[1] & 0xffffu), bf2f(gw[1] >> 16)};
        f32x4 o;
#pragma unroll
        for (int i = 0; i < 4; ++i) o[i] = g[i] * sigmoidf_(v[i] + bv[i]);
        st_bf16x4(CAT + (size_t)row * D_MODEL + col, o);
    }
    __device__ __forceinline__ void apply8(int row, int col, f32x4 a, f32x4 b) const {
        const u32x4 gw = *(const u32x4*)(GZ + (size_t)row * MAIN_W + col); const f32x4 b0 = *(const f32x4*)(bias + col), b1 = *(const f32x4*)(bias + col + 4);
        f32x4 oa, ob;
#pragma unroll
        for (int i = 0; i < 2; ++i) { oa[2 * i] = bf2f(gw[i] & 0xffffu) * sigmoidf_(a[2 * i] + b0[2 * i]); oa[2 * i + 1] = bf2f(gw[i] >> 16) * sigmoidf_(a[2 * i + 1] + b0[2 * i + 1]);
                                      ob[2 * i] = bf2f(gw[2 + i] & 0xffffu) * sigmoidf_(b[2 * i] + b1[2 * i]); ob[2 * i + 1] = bf2f(gw[2 + i] >> 16) * sigmoidf_(b[2 * i + 1] + b1[2 * i + 1]); }
        st_bf16x8(CAT + (size_t)row * D_MODEL + col, oa, ob);
    }
};
__device__ __forceinline__ unsigned pk_fp8x4(f32x4 v) { int w = __builtin_amdgcn_cvt_pk_fp8_f32(v[0], v[1], 0, false); w = __builtin_amdgcn_cvt_pk_fp8_f32(v[2], v[3], w, true); return (unsigned)w; }
struct EpiKV {
    unsigned char* KN8; unsigned char* V8P; const float* rkv;
    __device__ __forceinline__ void apply4(int, int, f32x4) const {}
    __device__ __forceinline__ void apply8(int row, int col, f32x4 a, f32x4 b) const { const float r = rkv[row];
        if (col < MAIN_W) { const float r4 = r * 0.25f; *(u32x2*)(KN8 + (size_t)row * MAIN_W + col) = (u32x2){pk_fp8x4(a * r4), pk_fp8x4(b * r4)}; }
        else { const unsigned w0 = pk_fp8x4(a * r), w1 = pk_fp8x4(b * r);
            const bool odd = (row & 1) != 0;
            const unsigned give = odd ? w0 : w1;
            const unsigned got = (unsigned)__builtin_amdgcn_update_dpp(0, (int)give, 0xB1, 0xF, 0xF, true);
            const unsigned ev = odd ? got : w0, od = odd ? w1 : got;
            const u32x2 o = {__builtin_amdgcn_perm(od, ev, 0x05010400u), __builtin_amdgcn_perm(od, ev, 0x07030602u)};
            *(u32x2*)(V8P + (size_t)(row >> 1) * (2 * MAIN_W) + (size_t)(col - MAIN_W + (odd ? 4 : 0)) * 2) = o; }
    }
};
__device__ __forceinline__ f32x4 rope4(f32x4 v, const float* cs, const float* sn, int idx) {
    const float c0 = cs[idx], s0 = sn[idx], c1 = cs[idx + 1], s1 = sn[idx + 1];
    return (f32x4){v[0] * c0 - v[1] * s0, v[1] * c0 + v[0] * s0, v[2] * c1 - v[3] * s1, v[3] * c1 + v[2] * s1};
}
struct EpiQ {
    unsigned char* Q; const float* rq; const float* cs; const float* sn;
    __device__ __forceinline__ void apply4(int row, int col, f32x4 v) const {
        v = v * (rq[row] * (C2_MLA * 4.f));
        const int j = col % 192;
        if (j >= 128) v = rope4(v, cs, sn, row * 32 + ((j - 128) >> 1));
        *(unsigned*)(Q + (size_t)row * NQ + col) = pk_fp8x4(v);
    }
    __device__ __forceinline__ void apply8(int row, int col, f32x4 a, f32x4 b) const {
        const float sc = rq[row] * (C2_MLA * 4.f); a = a * sc; b = b * sc;
        const int j = col % 192;
        if (j >= 128) { a = rope4(a, cs, sn, row * 32 + ((j - 128) >> 1)); b = rope4(b, cs, sn, row * 32 + ((j - 124) >> 1)); }
        *(u32x2*)(Q + (size_t)row * NQ + col) = (u32x2){pk_fp8x4(a), pk_fp8x4(b)};
    }
};


namespace pg8 {
constexpr int BM = 256, BK = 64, HALF = 128, HTB = HALF * BK * 2, STAGE_BYTES = 8 * HTB, NXCD = 8, WGM = 8;
__host__ __device__ __forceinline__ int lds_byte(int r, int c) { const int st = (r >> 4) * 2 + (c >> 5), rr = r & 15, cc = c & 31, ob = rr * 64 + cc * 2; return st * 1024 + (ob ^ (((ob >> 9) & 1) << 5)); }
__host__ __device__ __forceinline__ void stage_rc(int b, int& R, int& C) { const int st = b / 1024, sb = b % 1024, swz = sb ^ (((sb >> 9) & 1) << 5); R = (st >> 1) * 16 + swz / 64; C = (st & 1) * 32 + (swz % 64) / 2; }
__host__ __device__ __forceinline__ int perm32(int rho) { const int n = rho >> 4, i = rho & 15; return 8 * (i >> 2) + 4 * n + (i & 3); }
struct Unit { int pm, pn; };
struct Gemm { const bf16_t* A; const bf16_t* Bt; int M, N, K, lda, ldb; };
struct StaticOrder {
    int nM, nN, nwg, G, c;
    __device__ void init(int M, int N, int G_, int c_) { nM = M / BM; nN = N / BM; nwg = nM * nN; G = G_; c = c_; }
    __device__ bool next(int i, Unit& u) const {
        const long L = (long)i * G + c; if (L >= nwg) return false;
        int wgid = (int)L; { const int q = nwg / NXCD, r = nwg % NXCD, xcd = wgid % NXCD, off = wgid / NXCD; wgid = (xcd < r ? xcd * (q + 1) : r * (q + 1) + (xcd - r) * q) + off; }
        const int nig = WGM * nN, gid = wgid / nig, fm = gid * WGM, gsz = (nM - fm) < WGM ? (nM - fm) : WGM;
        u.pm = fm + ((wgid % nig) % gsz); u.pn = (wgid % nig) / gsz; return true;
    }
};
template <class Epi, bool ALIGN_EPI, bool SP2>
__device__ __forceinline__ void gemm_phase(LAS unsigned char* lds, const Gemm g, const StaticOrder& S, const Epi& E) {
    const int tid = opaque_tid(), wid = __builtin_amdgcn_readfirstlane(tid >> 6), lane = tid & 63, wr = wid >> 2, wc = wid & 3, fr = lane & 15, fq = lane >> 4;
    const int K = g.K, nt = K / BK;
    unsigned voffA[2], voffB[2];
#pragma unroll
    for (int i = 0; i < 2; ++i) { int R, C; stage_rc(tid * 16 + i * 8192, R, C); const int Rb = Epi::PERM ? ((R & ~31) + perm32(R & 31)) : R;
        voffA[i] = (unsigned)(R * g.lda + C) * 2u; voffB[i] = (unsigned)(Rb * g.ldb + C) * 2u; }
    const size_t kstep = (size_t)(BK * 2);
    const size_t hsA = (size_t)HALF * g.lda * 2, hsB = (size_t)HALF * g.ldb * 2;
    const size_t tsA = 2 * hsA, tsB = 2 * hsB;
    const unsigned ldsw = (unsigned)wid * 1024u;
    const int aoff = lds_byte(wr * 64 + fr, fq * 8), boff = lds_byte(wc * 32 + fr, fq * 8);
#define PG8_SA(b, h) (((b) * 2 + (h)) * HTB)
#define PG8_SB(b, h) ((4 + (b) * 2 + (h)) * HTB)
#define PG8_STAGE(bufoff, gbase, voff) do { _Pragma("unroll") for (int _i = 0; _i < 2; ++_i) \
        __builtin_amdgcn_global_load_lds((const unsigned*)((const char*)(gbase) + (voff)[_i]), (LAS unsigned*)(lds + (bufoff) + ldsw + _i * 8192), 16, 0, 0); } while (0)
#define PG8_LDA(dst, b, h) do { _Pragma("unroll") for (int m = 0; m < 4; ++m) _Pragma("unroll") for (int k = 0; k < 2; ++k) dst[m][k] = *(const LAS bf16x8*)(lds + PG8_SA(b, h) + aoff + m * 2048 + k * 1024); } while (0)
#define PG8_LDB(dst, b, h) do { _Pragma("unroll") for (int n = 0; n < 2; ++n) _Pragma("unroll") for (int k = 0; k < 2; ++k) dst[n][k] = *(const LAS bf16x8*)(lds + PG8_SB(b, h) + boff + n * 2048 + k * 1024); } while (0)
#define PG8_MMA(ai, bj, At, Bt) do { __builtin_amdgcn_s_setprio(1); _Pragma("unroll") for (int m = 0; m < 4; ++m) _Pragma("unroll") for (int n = 0; n < 2; ++n) _Pragma("unroll") for (int k = 0; k < 2; ++k) \
        acc[ai][bj][m][n] = __builtin_amdgcn_mfma_f32_16x16x32_bf16(Bt[n][k], At[m][k], acc[ai][bj][m][n], 0, 0, 0); __builtin_amdgcn_s_setprio(0); } while (0)
#define PG8_WAIT_V(n) asm volatile("s_waitcnt vmcnt(" #n ")" ::: "memory")
#define PG8_WAIT_L(n) asm volatile("s_waitcnt lgkmcnt(" #n ")" ::: "memory")
#define PG8_BAR __builtin_amdgcn_s_barrier()
#define PG8_SCHED __builtin_amdgcn_sched_barrier(0)
    Unit cur, nxt; int ui = 0;
    if (!S.next(0, cur)) return;
    f32x4 acc[2][2][4][2];
#pragma unroll
    for (int a = 0; a < 2; ++a)
#pragma unroll
        for (int b = 0; b < 2; ++b)
#pragma unroll
            for (int m = 0; m < 4; ++m)
#pragma unroll
                for (int n = 0; n < 2; ++n) acc[a][b][m][n] = (f32x4){0.f, 0.f, 0.f, 0.f};
    bf16x8 At[4][2], B0[2][2], B1[2][2];
    const char* cA = (const char*)g.A + (size_t)cur.pm * tsA; const char* cB = (const char*)g.Bt + (size_t)cur.pn * tsB;
    if constexpr (SP2) {
        PG8_STAGE(PG8_SB(0, 0), cB, voffB); PG8_STAGE(PG8_SB(0, 1), cB + hsB, voffB); PG8_STAGE(PG8_SA(0, 0), cA, voffA); PG8_STAGE(PG8_SA(0, 1), cA + hsA, voffA);
        if (wr == 1) PG8_BAR;
        PG8_WAIT_V(2); PG8_BAR;
        PG8_STAGE(PG8_SB(1, 0), cB + kstep, voffB); PG8_STAGE(PG8_SA(1, 0), cA + kstep, voffA); PG8_STAGE(PG8_SB(1, 1), cB + hsB + kstep, voffB);
        PG8_WAIT_V(6); PG8_BAR;
    } else {
        PG8_STAGE(PG8_SB(0, 0), cB, voffB); PG8_STAGE(PG8_SA(0, 0), cA, voffA); PG8_STAGE(PG8_SB(0, 1), cB + hsB, voffB); PG8_STAGE(PG8_SA(0, 1), cA + hsA, voffA);
        if (wr == 1) PG8_BAR;
        PG8_WAIT_V(4); PG8_BAR;
        PG8_STAGE(PG8_SB(1, 0), cB + kstep, voffB); PG8_STAGE(PG8_SA(1, 0), cA + kstep, voffA); PG8_STAGE(PG8_SB(1, 1), cB + hsB + kstep, voffB);
        PG8_WAIT_V(6); PG8_BAR;
    }
    for (;;) {
        const bool has_next = S.next(ui + 1, nxt);
        const char* nA = has_next ? (const char*)g.A + (size_t)nxt.pm * tsA : cA; const char* nB = has_next ? (const char*)g.Bt + (size_t)nxt.pn * tsB : cB;
        for (int t = 0; t < nt; t += 2) {
            const bool last = (t == nt - 2);
            const char* a1 = cA + (size_t)(t + 1) * kstep;
            const char* a2 = last ? nA : cA + (size_t)(t + 2) * kstep; const char* b2 = last ? nB : cB + (size_t)(t + 2) * kstep;
            const char* a3 = a2 + kstep; const char* b3 = b2 + kstep;
            if constexpr (SP2) {
            PG8_LDB(B0, 0, 0); PG8_LDB(B1, 0, 1); PG8_SCHED; PG8_LDA(At, 0, 0); PG8_STAGE(PG8_SA(1, 1), a1 + hsA, voffA);
            PG8_WAIT_V(8); PG8_WAIT_L(0); PG8_BAR; PG8_MMA(0, 0, At, B0); PG8_MMA(0, 1, At, B1); PG8_BAR; PG8_SCHED;
            PG8_LDA(At, 0, 1); PG8_STAGE(PG8_SB(0, 0), b2, voffB); PG8_STAGE(PG8_SB(0, 1), b2 + hsB, voffB); PG8_STAGE(PG8_SA(0, 0), a2, voffA);
            PG8_WAIT_V(8); PG8_WAIT_L(0); PG8_BAR; PG8_MMA(1, 0, At, B0); PG8_MMA(1, 1, At, B1); PG8_BAR; PG8_SCHED;
            PG8_LDB(B0, 1, 0); PG8_LDB(B1, 1, 1); PG8_SCHED; PG8_LDA(At, 1, 0); PG8_STAGE(PG8_SA(0, 1), a2 + hsA, voffA);
            PG8_WAIT_V(8); PG8_WAIT_L(0); PG8_BAR; PG8_MMA(0, 0, At, B0); PG8_MMA(0, 1, At, B1); PG8_BAR; PG8_SCHED;
            PG8_LDA(At, 1, 1); PG8_STAGE(PG8_SB(1, 0), b3, voffB); PG8_STAGE(PG8_SB(1, 1), b3 + hsB, voffB); PG8_STAGE(PG8_SA(1, 0), a3, voffA);
            PG8_WAIT_V(8); PG8_WAIT_L(0); PG8_BAR; PG8_MMA(1, 0, At, B0); PG8_MMA(1, 1, At, B1); PG8_BAR; PG8_SCHED;
            } else {
            PG8_LDB(B0, 0, 0); PG8_SCHED; PG8_LDA(At, 0, 0); PG8_STAGE(PG8_SA(1, 1), a1 + hsA, voffA);
            PG8_WAIT_L(8); PG8_BAR; PG8_WAIT_L(0); PG8_MMA(0, 0, At, B0); PG8_BAR; PG8_SCHED;
            PG8_LDB(B1, 0, 1); PG8_STAGE(PG8_SB(0, 0), b2, voffB);
            PG8_BAR; PG8_WAIT_L(0); PG8_MMA(0, 1, At, B1); PG8_BAR;
            PG8_LDA(At, 0, 1); PG8_STAGE(PG8_SA(0, 0), a2, voffA);
            PG8_BAR; PG8_WAIT_L(0); PG8_MMA(1, 0, At, B0); PG8_BAR; PG8_SCHED;
            PG8_STAGE(PG8_SB(0, 1), b2 + hsB, voffB);
            PG8_WAIT_V(6); PG8_BAR; PG8_MMA(1, 1, At, B1); PG8_BAR;
            PG8_LDB(B0, 1, 0); PG8_SCHED; PG8_LDA(At, 1, 0); PG8_STAGE(PG8_SA(0, 1), a2 + hsA, voffA);
            PG8_WAIT_L(8); PG8_BAR; PG8_WAIT_L(0); PG8_MMA(0, 0, At, B0); PG8_BAR; PG8_SCHED;
            PG8_LDB(B1, 1, 1); PG8_STAGE(PG8_SB(1, 0), b3, voffB);
            PG8_BAR; PG8_WAIT_L(0); PG8_MMA(0, 1, At, B1); PG8_BAR;
            PG8_LDA(At, 1, 1); PG8_STAGE(PG8_SA(1, 0), a3, voffA);
            PG8_BAR; PG8_WAIT_L(0); PG8_MMA(1, 0, At, B0); PG8_BAR; PG8_SCHED;
            PG8_STAGE(PG8_SB(1, 1), b3 + hsB, voffB);
            PG8_WAIT_V(6); PG8_BAR; PG8_MMA(1, 1, At, B1); PG8_BAR;
            }
        }
        if constexpr (ALIGN_EPI) { if (wr == 0) PG8_BAR; }
        E(acc, cur, wr, wc, fr, fq);
        if (!has_next) break;
#pragma unroll
        for (int a = 0; a < 2; ++a)
#pragma unroll
            for (int b = 0; b < 2; ++b)
#pragma unroll
                for (int m = 0; m < 4; ++m)
#pragma unroll
                    for (int n = 0; n < 2; ++n) acc[a][b][m][n] = (f32x4){0.f, 0.f, 0.f, 0.f};
        cur = nxt; cA = nA; cB = nB; ++ui;
        if constexpr (ALIGN_EPI) { if (wr == 1) PG8_BAR; }
    }
    PG8_WAIT_V(0);
    if constexpr (!ALIGN_EPI) { if (wr == 0) PG8_BAR; }
    PG8_BAR;
#undef PG8_SA
#undef PG8_SB
#undef PG8_STAGE
#undef PG8_LDA
#undef PG8_LDB
#undef PG8_MMA
#undef PG8_WAIT_V
#undef PG8_WAIT_L
#undef PG8_BAR
#undef PG8_SCHED
}
}
template <class E4, bool PERM_> struct EpiA {
    static constexpr bool PERM = PERM_; E4 e;
    __device__ __forceinline__ void operator()(const f32x4 (&acc)[2][2][4][2], const pg8::Unit& u, int wr, int wc, int fr, int fq) const {
#pragma unroll
        for (int ai = 0; ai < 2; ++ai)
#pragma unroll
            for (int m = 0; m < 4; ++m) { const int row = u.pm * 256 + ai * 128 + wr * 64 + m * 16 + fr;
#pragma unroll
                for (int bj = 0; bj < 2; ++bj) { const int cb = u.pn * 256 + bj * 128 + wc * 32;
                    if (PERM_) { e.apply8(row, cb + 8 * fq, acc[ai][bj][m][0], acc[ai][bj][m][1]); }
                    else { e.apply4(row, cb + 4 * fq, acc[ai][bj][m][0]); e.apply4(row, cb + 16 + 4 * fq, acc[ai][bj][m][1]); } } }
    }
};
template <class E4, bool PERM_>
__device__ __forceinline__ void gemm_fast(LAS unsigned char* lds, const bf16_t* A, int lda, const bf16_t* Bt, int ldb, int M, int N, int K, const E4& e, int G = -1, int c = -1) {
    pg8::StaticOrder S; S.init(M, N, G > 0 ? G : (int)gridDim.x, G > 0 ? c : (int)blockIdx.x);
    const pg8::Gemm g{A, Bt, M, N, K, lda, ldb};
    const EpiA<E4, PERM_> E{e};
    pg8::gemm_phase<EpiA<E4, PERM_>, true, true>(lds, g, S, E);
}

__device__ __forceinline__ float wave_sum(float v, int lane) {
#pragma unroll
    for (int o = 1; o < 64; o <<= 1) v += shfl_idx(v, lane ^ o);
    return v;
}
__device__ __forceinline__ void rms_row(const bf16_t* __restrict__ HB, float* __restrict__ rq, float* __restrict__ rkv, int row, int lane) {
    const u32x4 a = *(const u32x4*)(HB + (size_t)row * NBP + HB_CQ + lane * 8), b = *(const u32x4*)(HB + (size_t)row * NBP + HB_CKV + lane * 8);
    float sa = 0.f, sb = 0.f;
#pragma unroll
    for (int i = 0; i < 4; ++i) { float x = bf2f(a[i] & 0xffffu), y = bf2f(a[i] >> 16); sa += x * x + y * y; x = bf2f(b[i] & 0xffffu); y = bf2f(b[i] >> 16); sb += x * x + y * y; }
    sa = wave_sum(sa, lane); sb = wave_sum(sb, lane);
    if (lane == 0) { rq[row] = 1.f / sqrtf(sa * (1.f / 512.f) + RMS_EPS); rkv[row] = 1.f / sqrtf(sb * (1.f / 512.f) + RMS_EPS); }
}
template <bool XBF, bool OUTF>
__device__ __forceinline__ void ln_rows2(const void* __restrict__ xin, const bf16_t* __restrict__ Y, float* __restrict__ out, const float* __restrict__ g, const float* __restrict__ b, bf16_t* __restrict__ XB, int row0, int lane) {
    f32x4 v[2][8]; float s[2] = {0.f, 0.f};
#pragma unroll
    for (int k = 0; k < 2; ++k) { const u32x2* yr = (const u32x2*)(Y + (size_t)(row0 + k) * D_MODEL) + lane;
#pragma unroll
        for (int j = 0; j < 8; ++j) { f32x4 xv;
            if (XBF) { const u32x2 xw = __builtin_nontemporal_load((const u32x2*)((const bf16_t*)xin + (size_t)(row0 + k) * D_MODEL) + lane + 64 * j); xv = (f32x4){bf2f(xw[0] & 0xffffu), bf2f(xw[0] >> 16), bf2f(xw[1] & 0xffffu), bf2f(xw[1] >> 16)}; }
            else xv = __builtin_nontemporal_load((const f32x4*)((const float*)xin + (size_t)(row0 + k) * D_MODEL) + lane + 64 * j);
            const u32x2 yw = __builtin_nontemporal_load(yr + 64 * j);
            v[k][j] = xv * ALPHA + (f32x4){bf2f(yw[0] & 0xffffu), bf2f(yw[0] >> 16), bf2f(yw[1] & 0xffffu), bf2f(yw[1] >> 16)}; } }
#pragma unroll
    for (int k = 0; k < 2; ++k)
#pragma unroll
        for (int j = 0; j < 8; ++j) s[k] += (v[k][j][0] + v[k][j][1]) + (v[k][j][2] + v[k][j][3]);
#pragma unroll
    for (int o = 1; o < 64; o <<= 1) { s[0] += shfl_idx(s[0], lane ^ o); s[1] += shfl_idx(s[1], lane ^ o); }
    float s2[2] = {0.f, 0.f};
#pragma unroll
    for (int k = 0; k < 2; ++k) { const float mean = s[k] * (1.f / D_MODEL);
#pragma unroll
        for (int j = 0; j < 8; ++j) { v[k][j] = v[k][j] - mean; s2[k] += (v[k][j][0] * v[k][j][0] + v[k][j][1] * v[k][j][1]) + (v[k][j][2] * v[k][j][2] + v[k][j][3] * v[k][j][3]); } }
#pragma unroll
    for (int o = 1; o < 64; o <<= 1) { s2[0] += shfl_idx(s2[0], lane ^ o); s2[1] += shfl_idx(s2[1], lane ^ o); }
#pragma unroll
    for (int k = 0; k < 2; ++k) { const float rstd = 1.f / sqrtf(s2[k] * (1.f / D_MODEL) + LN_EPS);
#pragma unroll
        for (int j = 0; j < 8; ++j) { const int c = (64 * j + lane) * 4; const f32x4 gg = *(const f32x4*)(g + c), bb = *(const f32x4*)(b + c);
            const f32x4 o = v[k][j] * rstd * gg + bb;
            if (OUTF) __builtin_nontemporal_store(o, (f32x4*)(out + (size_t)(row0 + k) * D_MODEL) + lane + 64 * j);
            if (XB) *(u32x2*)(XB + (size_t)(row0 + k) * D_MODEL + c) = (u32x2){cvtpk_(o[0], o[1]), cvtpk_(o[2], o[3])}; } }
}
template <bool ROPE>
__device__ __forceinline__ void skinny_unit(LAS unsigned char* L, const bf16_t* __restrict__ A, const bf16_t* __restrict__ Wt, int m0, int n0, bf16_t* __restrict__ C, int ldc, const float* __restrict__ cs, const float* __restrict__ sn) {
    const int tid = opaque_tid(), w = __builtin_amdgcn_readfirstlane(tid >> 6), lane = tid & 63, r = lane & 31, h = lane >> 5;
    f32x16 acc0, acc1;
#pragma unroll
    for (int e = 0; e < 16; ++e) { acc0[e] = 0.f; acc1[e] = 0.f; }
    const bf16_t* a0 = A + (size_t)(m0 + r) * D_MODEL + w * 256 + 8 * h; const bf16_t* b0 = Wt + (size_t)(n0 + r) * D_MODEL + w * 256 + 8 * h; const bf16_t* b1 = b0 + (size_t)32 * D_MODEL;
#pragma unroll
    for (int k = 0; k < 256; k += 16) { const bf16x8 fa = *(const bf16x8*)(a0 + k), fb0 = *(const bf16x8*)(b0 + k), fb1 = *(const bf16x8*)(b1 + k);
        acc0 = MFMA32(fb0, fa, acc0); acc1 = MFMA32(fb1, fa, acc1); }
    LAS float* red = (LAS float*)L;
#pragma unroll
    for (int e = 0; e < 16; ++e) { red[w * 2048 + e * 64 + lane] = acc0[e]; red[w * 2048 + (16 + e) * 64 + lane] = acc1[e]; }
    __syncthreads();
    {
        const int m = tid & 31, cg = tid >> 5, tile = cg >> 3, q = cg & 7, hh = q & 1, e0 = 4 * (q >> 1);
        f32x4 v = {0.f, 0.f, 0.f, 0.f};
#pragma unroll
        for (int w2 = 0; w2 < 8; ++w2)
#pragma unroll
            for (int j = 0; j < 4; ++j) v[j] += red[w2 * 2048 + (tile * 16 + e0 + j) * 64 + hh * 32 + m];
        const int row = m0 + m, col = 4 * cg;
        if (ROPE) { v = rope4(v, cs, sn, row * 32 + (col >> 1)); *(unsigned*)((unsigned char*)C + (size_t)row * ldc + n0 + col) = pk_fp8x4(v * 0.25f); }
        else st_bf16x4(C + (size_t)row * ldc + n0 + col, v);
    }
    __syncthreads();
}

constexpr int S5_BB = 0, S5_CF = 4096, S5_AT = 12288, S5_A64 = 12800, S5_A2K = 13312, S5_PWC = 13824, S5_EW = 14336, S5_W = 18432, S5_A8 = S5_W + 32768, S5_BYTES = S5_A8 + 512;
typedef float f32x2 __attribute__((ext_vector_type(2)));
typedef __bf16 bf16x2_t __attribute__((ext_vector_type(2)));
__device__ __forceinline__ unsigned cvtpk(float lo, float hi) { const f32x2 v = {lo, hi}; const bf16x2_t b = __builtin_convertvector(v, bf16x2_t); return __builtin_bit_cast(unsigned, b); }
__device__ __forceinline__ f32x2 cmul(f32x2 a, f32x2 b) { return (f32x2){a.x * b.x - a.y * b.y, a.x * b.y + a.y * b.x}; }
#define S5_PIDX(t_, q_) (16 * (t_) + ((q_) & 1) + 4 * ((q_) >> 1) + 2 * hh)
#define S5_STEP(UB_, BB_) do { _Pragma("unroll") for (int t_ = 0; t_ < 4; ++t_) { _Pragma("unroll") for (int q_ = 0; q_ < 8; ++q_) { const float xr_ = X[t_][2 * q_], xi_ = X[t_][2 * q_ + 1]; \
            float a_ = Ar[t_][q_].x * xr_, b_ = Ar[t_][q_].x * xi_; asm("" : "+v"(a_), "+v"(b_)); \
            a_ = fmaf(-Ar[t_][q_].y, xi_, a_); b_ = fmaf(Ar[t_][q_].y, xr_, b_); asm("" : "+v"(a_), "+v"(b_)); X[t_][2 * q_] = a_; X[t_][2 * q_ + 1] = b_; } \
            X[t_] = MFMA32(BB_(t_), (UB_), X[t_]); } } while (0)
#define S5_BB_REG(t_) bbf[t_]
#define S5_BB_LDS(t_) (*(const volatile LAS bf16x8*)(L + S5_BB + ((t_) * 64 + lane) * 16))
__device__ __forceinline__ void s5_unit(LAS unsigned char* L, int unit, const bf16_t* __restrict__ H, const float* __restrict__ lam_re, const float* __restrict__ lam_im, const float* __restrict__ log_dt,
                                        const float* __restrict__ b_re, const float* __restrict__ b_im, const float* __restrict__ c_re, const float* __restrict__ c_im,
                                        const float* __restrict__ d_skip, bf16_t* __restrict__ G, bf16_t* __restrict__ GZ) {
    const int tid = opaque_tid(), lane = tid & 63, w = __builtin_amdgcn_readfirstlane(tid >> 6), col = lane & 31, hh = lane >> 5;
    const int b = unit / 96, g = unit % 96;
    if (tid < 64) {
        const int p = tid, tau = p >> 4, i = p & 15;
        const float dt = expf(log_dt[g]), lr = lam_re[g * 64 + p], li = lam_im[g * 64 + p];
        const float mag = expf(lr * dt), a_re = mag * cosf(li * dt), a_im = mag * sinf(li * dt);
        const float den = lr * lr + li * li, n_re = a_re - 1.f, n_im = a_im;
        const float cf_re = (n_re * lr + n_im * li) / den, cf_im = (n_im * lr - n_re * li) / den;
        ((LAS f32x2*)(L + S5_AT))[p] = (f32x2){a_re, a_im};
        { f32x2 m = {a_re, a_im};
#pragma unroll
          for (int i2 = 0; i2 < 6; ++i2) m = cmul(m, m);
          ((LAS f32x2*)(L + S5_A64))[p] = m;
          { f32x2 m8 = {a_re, a_im}; m8 = cmul(m8, m8); m8 = cmul(m8, m8); m8 = cmul(m8, m8); ((LAS f32x2*)(L + S5_A8))[p] = m8; }
#pragma unroll
          for (int i2 = 0; i2 < 5; ++i2) m = cmul(m, m);
          ((LAS f32x2*)(L + S5_A2K))[p] = m;
          const double tq = 64.0 * (double)li * (double)dt * 0.15915494309189535;
          ((LAS f32x2*)(L + S5_PWC))[p] = (f32x2){64.f * lr * dt * LOG2E, (float)(tq - floor(tq))}; }
#pragma unroll
        for (int h2 = 0; h2 < 2; ++h2) {
            u32x4 wr_, wi_;
#pragma unroll
            for (int j = 0; j < 4; ++j) {
                const float br0 = b_re[(g * 64 + p) * 16 + 8 * h2 + 2 * j], bi0 = b_im[(g * 64 + p) * 16 + 8 * h2 + 2 * j], br1 = b_re[(g * 64 + p) * 16 + 8 * h2 + 2 * j + 1], bi1 = b_im[(g * 64 + p) * 16 + 8 * h2 + 2 * j + 1];
                wr_[j] = cvtpk(cf_re * br0 - cf_im * bi0, cf_re * br1 - cf_im * bi1); wi_[j] = cvtpk(cf_re * bi0 + cf_im * br0, cf_re * bi1 + cf_im * br1); }
            *(LAS u32x4*)(L + S5_BB + (tau * 64 + h2 * 32 + 2 * i) * 16) = wr_;
            *(LAS u32x4*)(L + S5_BB + (tau * 64 + h2 * 32 + 2 * i + 1) * 16) = wi_;
            f32x2 ak = {1.f, 0.f};
#pragma unroll 1
            for (int k = 0; k < 8; ++k) { u32x4 vr_, vi_;
#pragma unroll
                for (int j = 0; j < 4; ++j) {
                    const float br0 = b_re[(g * 64 + p) * 16 + 8 * h2 + 2 * j], bi0 = b_im[(g * 64 + p) * 16 + 8 * h2 + 2 * j], br1 = b_re[(g * 64 + p) * 16 + 8 * h2 + 2 * j + 1], bi1 = b_im[(g * 64 + p) * 16 + 8 * h2 + 2 * j + 1];
                    const float Br0 = cf_re * br0 - cf_im * bi0, Bi0 = cf_re * bi0 + cf_im * br0, Br1 = cf_re * br1 - cf_im * bi1, Bi1 = cf_re * bi1 + cf_im * br1;
                    vr_[j] = cvtpk(ak.x * Br0 - ak.y * Bi0, ak.x * Br1 - ak.y * Bi1); vi_[j] = cvtpk(ak.x * Bi0 + ak.y * Br0, ak.x * Bi1 + ak.y * Br1); }
                *(LAS u32x4*)(L + S5_W + ((k * 4 + tau) * 64 + h2 * 32 + 2 * i) * 16) = vr_;
                *(LAS u32x4*)(L + S5_W + ((k * 4 + tau) * 64 + h2 * 32 + 2 * i + 1) * 16) = vi_;
                ak = cmul(ak, (f32x2){a_re, a_im}); }
        }
    }
    {
        const int f = tid >> 6, tau = f >> 1, kk = f & 1, rho = lane & 31, h2 = lane >> 5;
        const int hq = rho >> 2, hp = (hq == 1) ? rho + 4 : (hq == 2) ? rho - 4 : rho;
        float v[8];
#pragma unroll
        for (int j = 0; j < 8; ++j) { const int row = 16 * kk + 8 * (j >> 2) + 4 * h2 + (j & 3), p = 16 * tau + (row >> 1);
            float c = 0.f; if (rho < 16) c = (row & 1) ? -c_im[(g * 16 + hp) * 64 + p] : c_re[(g * 16 + hp) * 64 + p]; v[j] = c; }
        *(LAS u32x4*)(L + S5_CF + (f * 64 + lane) * 16) = (u32x4){cvtpk(v[0], v[1]), cvtpk(v[2], v[3]), cvtpk(v[4], v[5]), cvtpk(v[6], v[7])};
    }
    __syncthreads();
    const size_t row0 = (size_t)b * SEQ + (size_t)(32 * w + col) * 64;
    const bf16_t* up = H + row0 * NA + H_U + g * 16 + 8 * hh;
    f32x16 X[4];
#pragma unroll
    for (int t = 0; t < 4; ++t)
#pragma unroll
        for (int e = 0; e < 16; ++e) X[t][e] = 0.f;
    {
        f32x2 Ar[4][8];
#pragma unroll
        for (int t = 0; t < 4; ++t)
#pragma unroll
            for (int q = 0; q < 8; ++q) Ar[t][q] = ((const LAS f32x2*)(L + S5_A8))[S5_PIDX(t, q)];
#define S5_ROT() do { _Pragma("unroll") for (int t_ = 0; t_ < 4; ++t_) { _Pragma("unroll") for (int q_ = 0; q_ < 8; ++q_) { const float xr_ = X[t_][2 * q_], xi_ = X[t_][2 * q_ + 1]; \
            float a_ = Ar[t_][q_].x * xr_, b_ = Ar[t_][q_].x * xi_; asm("" : "+v"(a_), "+v"(b_)); \
            a_ = fmaf(-Ar[t_][q_].y, xi_, a_); b_ = fmaf(Ar[t_][q_].y, xr_, b_); asm("" : "+v"(a_), "+v"(b_)); X[t_][2 * q_] = a_; X[t_][2 * q_ + 1] = b_; } } } while (0)
#define S5_WF(k_, t_) (*(const volatile LAS bf16x8*)(L + S5_W + (((k_) * 4 + (t_)) * 64 + lane) * 16))
#define S5_ACC4(UB_, k_) do { _Pragma("unroll") for (int t_ = 0; t_ < 4; ++t_) X[t_] = MFMA32(S5_WF(k_, t_), (UB_), X[t_]); } while (0)
        bf16x8 ub[4], un[4];
#pragma unroll
        for (int i = 0; i < 4; ++i) ub[i] = *(const bf16x8*)(up + (size_t)i * NA);
#pragma unroll 1
        for (int s0 = 0; s0 < 64; s0 += 8) {
#pragma unroll
            for (int i = 0; i < 4; ++i) un[i] = *(const bf16x8*)(up + (size_t)(s0 + 4 + i) * NA);
            if (s0 != 0) S5_ROT();
            S5_ACC4(ub[0], 7); S5_ACC4(ub[1], 6); S5_ACC4(ub[2], 5); S5_ACC4(ub[3], 4); __builtin_amdgcn_sched_barrier(0);
            const int sn = (s0 + 8 < 64) ? s0 + 8 : s0;
#pragma unroll
            for (int i = 0; i < 4; ++i) ub[i] = *(const bf16x8*)(up + (size_t)(sn + i) * NA);
            S5_ACC4(un[0], 3); S5_ACC4(un[1], 2); S5_ACC4(un[2], 1); S5_ACC4(un[3], 0); __builtin_amdgcn_sched_barrier(0);
        }
#undef S5_ACC4
#undef S5_WF
#undef S5_ROT
    }
#define S5_SCAN_HALF(t_, q0_) do { f32x2 Mk[4]; _Pragma("unroll") for (int q = 0; q < 4; ++q) Mk[q] = ((const LAS f32x2*)(L + S5_A64))[S5_PIDX(t_, (q0_) + q)]; \
        _Pragma("unroll") for (int k = 0; k < 5; ++k) { const int d = 1 << k; const bool ok = col >= d; const int src = (lane - d) & 63; \
            _Pragma("unroll") for (int q = 0; q < 4; ++q) { const int e_ = 2 * ((q0_) + q); float sr = shfl_idx(X[t_][e_], src), si = shfl_idx(X[t_][e_ + 1], src); sr = ok ? sr : 0.f; si = ok ? si : 0.f; \
                X[t_][e_] += Mk[q].x * sr - Mk[q].y * si; X[t_][e_ + 1] += Mk[q].x * si + Mk[q].y * sr; if (k < 4) Mk[q] = cmul(Mk[q], Mk[q]); } } \
        if (col == 31) { _Pragma("unroll") for (int q = 0; q < 4; ++q) ((LAS f32x2*)(L + S5_EW))[w * 64 + S5_PIDX(t_, (q0_) + q)] = (f32x2){X[t_][2 * ((q0_) + q)], X[t_][2 * ((q0_) + q) + 1]}; } \
        __builtin_amdgcn_sched_barrier(0); } while (0)
    S5_SCAN_HALF(0, 0); S5_SCAN_HALF(0, 4); S5_SCAN_HALF(1, 0); S5_SCAN_HALF(1, 4); S5_SCAN_HALF(2, 0); S5_SCAN_HALF(2, 4); S5_SCAN_HALF(3, 0); S5_SCAN_HALF(3, 4);
    __syncthreads();
#define S5_CARRY_HALF(t_, q0_) do { f32x2 gin[4]; _Pragma("unroll") for (int q = 0; q < 4; ++q) gin[q] = (f32x2){0.f, 0.f}; \
        for (int w2 = 0; w2 < w; ++w2) { _Pragma("unroll") for (int q = 0; q < 4; ++q) { const f32x2 m = ((const LAS f32x2*)(L + S5_A2K))[S5_PIDX(t_, (q0_) + q)]; \
            const f32x2 e = ((const LAS f32x2*)(L + S5_EW))[w2 * 64 + S5_PIDX(t_, (q0_) + q)]; gin[q] = cmul(m, gin[q]) + e; } } \
        const int srcp = (lane - 1) & 63; const bool okp = col >= 1; float pr[4], pi[4]; \
        _Pragma("unroll") for (int q = 0; q < 4; ++q) { pr[q] = shfl_idx(X[t_][2 * ((q0_) + q)], srcp); pi[q] = shfl_idx(X[t_][2 * ((q0_) + q) + 1], srcp); } \
        _Pragma("unroll") for (int q = 0; q < 4; ++q) { const f32x2 pc = ((const LAS f32x2*)(L + S5_PWC))[S5_PIDX(t_, (q0_) + q)]; \
            const float tr = (float)col * pc.y, fr = tr - floorf(tr), mg = __builtin_amdgcn_exp2f((float)col * pc.x); \
            const f32x2 pw = {mg * __builtin_amdgcn_cosf(fr), mg * __builtin_amdgcn_sinf(fr)}; const f32x2 c = cmul(pw, gin[q]); \
            X[t_][2 * ((q0_) + q)] = (okp ? pr[q] : 0.f) + c.x; X[t_][2 * ((q0_) + q) + 1] = (okp ? pi[q] : 0.f) + c.y; } \
        __builtin_amdgcn_sched_barrier(0); } while (0)
    S5_CARRY_HALF(0, 0); S5_CARRY_HALF(0, 4); S5_CARRY_HALF(1, 0); S5_CARRY_HALF(1, 4); S5_CARRY_HALF(2, 0); S5_CARRY_HALF(2, 4); S5_CARRY_HALF(3, 0); S5_CARRY_HALF(3, 4);
    {
        f32x2 Ar[4][8];
#pragma unroll
        for (int t = 0; t < 4; ++t)
#pragma unroll
            for (int q = 0; q < 8; ++q) Ar[t][q] = ((const volatile LAS f32x2*)(L + S5_AT))[S5_PIDX(t, q)];
        float dsk[8];
#pragma unroll
        for (int e = 0; e < 8; ++e) dsk[e] = d_skip[g * 16 + 8 * hh + e];
        bf16_t* gp = G + row0 * MAIN_W + g * 16 + 8 * hh; bf16_t* gzp = GZ + row0 * MAIN_W + g * 16 + 8 * hh;
        const bf16_t* zp = up + (H_Z - H_U);
        bf16x8 ub[2], un[2], zb[2], zn[2];
#pragma unroll
        for (int i = 0; i < 2; ++i) { ub[i] = *(const bf16x8*)(up + (size_t)i * NA); zb[i] = *(const bf16x8*)(zp + (size_t)i * NA); }
#pragma unroll 1
        for (int s0 = 0; s0 < 64; s0 += 2) {
            const int sn = (s0 + 2 < 64) ? s0 + 2 : s0;
#pragma unroll
            for (int i = 0; i < 2; ++i) { un[i] = *(const bf16x8*)(up + (size_t)(sn + i) * NA); zn[i] = *(const bf16x8*)(zp + (size_t)(sn + i) * NA); }
#pragma unroll
            for (int i = 0; i < 2; ++i) {
                S5_STEP(ub[i], S5_BB_LDS); __builtin_amdgcn_sched_barrier(0);
                f32x16 Y;
#pragma unroll
                for (int e = 0; e < 16; ++e) Y[e] = 0.f;
#pragma unroll
                for (int t = 0; t < 4; ++t)
#pragma unroll
                    for (int kk = 0; kk < 2; ++kk) {
                        const u32x4 pw = {cvtpk(X[t][8 * kk], X[t][8 * kk + 1]), cvtpk(X[t][8 * kk + 2], X[t][8 * kk + 3]), cvtpk(X[t][8 * kk + 4], X[t][8 * kk + 5]), cvtpk(X[t][8 * kk + 6], X[t][8 * kk + 7])};
                        const bf16x8 cf = *(const volatile LAS bf16x8*)(L + S5_CF + ((t * 2 + kk) * 64 + lane) * 16);
                        Y = MFMA32(cf, __builtin_bit_cast(bf16x8, pw), Y);
                    }
                const u32x4 uw = __builtin_bit_cast(u32x4, ub[i]), zw = __builtin_bit_cast(u32x4, zb[i]);
                float gl[8], gz[8];
#pragma unroll
                for (int e = 0; e < 4; ++e) {
                    gl[2 * e] = gelu_tanh(Y[2 * e] + dsk[2 * e] * bf2f(uw[e] & 0xffffu)); gl[2 * e + 1] = gelu_tanh(Y[2 * e + 1] + dsk[2 * e + 1] * bf2f(uw[e] >> 16));
                    gz[2 * e] = gl[2 * e] * siluf_(bf2f(zw[e] & 0xffffu)); gz[2 * e + 1] = gl[2 * e + 1] * siluf_(bf2f(zw[e] >> 16)); }
                *(u32x4*)(gp + (size_t)(s0 + i) * MAIN_W) = (u32x4){cvtpk(gl[0], gl[1]), cvtpk(gl[2], gl[3]), cvtpk(gl[4], gl[5]), cvtpk(gl[6], gl[7])};
                *(u32x4*)(gzp + (size_t)(s0 + i) * MAIN_W) = (u32x4){cvtpk(gz[0], gz[1]), cvtpk(gz[2], gz[3]), cvtpk(gz[4], gz[5]), cvtpk(gz[6], gz[7])};
                __builtin_amdgcn_sched_barrier(0);
            }
#pragma unroll
            for (int i = 0; i < 2; ++i) { ub[i] = un[i]; zb[i] = zn[i]; }
        }
    }
    __syncthreads();
}


namespace att {
constexpr int KSUB = 8192, SHM_K = 3 * KSUB, SHM_V = 16384, A_K = 0, A_V = 2 * SHM_K, A_WS = A_V + 3 * SHM_V, A_OST = A_WS + 2048, A_BYTES = A_OST + 8 * 4096;
constexpr float THRL = 6.f;
typedef short s16x4 __attribute__((ext_vector_type(4)));
#define SBAR() __builtin_amdgcn_sched_barrier(0)
__device__ __forceinline__ int v_rd_base(int lane) { return ((lane & 3) << 3) | (((lane >> 2) & 3) << 6) | (((lane >> 4) & 1) << 5) | (((lane >> 5) & 1) << 8); }
constexpr int v_rd_off(int d0, int ks, int half) { return d0 * 512 + ks * 4096 + half * 2048; }
__device__ __forceinline__ void mask_tile(f32x16& p0, f32x16& p1, int dq) {
    const float NEG = -__builtin_inff();
#pragma unroll
    for (int r = 0; r < 16; ++r) { const int c = (r & 3) + 8 * (r >> 2); if (dq - c < 0) p0[r] = NEG; if (dq - c - 32 < 0) p1[r] = NEG; }
}
__device__ __forceinline__ void partialSM(f32x16& p0, f32x16& p1, float& m_reg, float& alpha) {
    float pmax = p0[0];
#pragma unroll
    for (int r = 1; r < 16; ++r) pmax = fmaxf(pmax, p0[r]);
#pragma unroll
    for (int r = 0; r < 16; ++r) pmax = fmaxf(pmax, p1[r]);
    { auto rr = __builtin_amdgcn_permlane32_swap(__float_as_uint(pmax), __float_as_uint(pmax), false, false); pmax = fmaxf(__uint_as_float(rr[0]), __uint_as_float(rr[1])); }
    float mn;
    if (__builtin_expect(__all(pmax - m_reg <= THRL), 1)) { mn = m_reg; alpha = 1.f; }
    else { mn = fmaxf(m_reg, pmax); alpha = __builtin_amdgcn_exp2f(m_reg - mn); m_reg = mn; }
#pragma unroll
    for (int r = 0; r < 16; ++r) { p0[r] -= mn; p1[r] -= mn; }
#pragma unroll
    for (int r = 0; r < 16; ++r) p0[r] = __builtin_amdgcn_exp2f(p0[r]);
}
template <bool FIRST>
__device__ __forceinline__ void partialSM_rel(f32x16& p0, f32x16& p1, float& m_reg, float& alpha, f32x16& negm) {
    float pmax = p0[0];
#pragma unroll
    for (int r = 1; r < 16; ++r) pmax = fmaxf(pmax, p0[r]);
#pragma unroll
    for (int r = 0; r < 16; ++r) pmax = fmaxf(pmax, p1[r]);
    { auto rr = __builtin_amdgcn_permlane32_swap(__float_as_uint(pmax), __float_as_uint(pmax), false, false); pmax = fmaxf(__uint_as_float(rr[0]), __uint_as_float(rr[1])); }
    if (!FIRST && __builtin_expect(__all(pmax <= THRL), 1)) { alpha = 1.f; }
    else { const float d = FIRST ? pmax : fmaxf(pmax, 0.f); alpha = FIRST ? 0.f : __builtin_amdgcn_exp2f(-d); m_reg += d;
#pragma unroll
        for (int r = 0; r < 16; ++r) { p0[r] -= d; p1[r] -= d; negm[r] = -m_reg; } }
#pragma unroll
    for (int r = 0; r < 16; ++r) p0[r] = __builtin_amdgcn_exp2f(p0[r]);
}
template <bool FIRST>
__device__ __forceinline__ void partialSM_rel8(f32x16& p0, f32x16& p1, float& m_reg, float& alpha, f32x16& negm) {
    float pmax = p0[0];
#pragma unroll
    for (int r = 1; r < 16; ++r) pmax = fmaxf(pmax, p0[r]);
#pragma unroll
    for (int r = 0; r < 16; ++r) pmax = fmaxf(pmax, p1[r]);
    { auto rr = __builtin_amdgcn_permlane32_swap(__float_as_uint(pmax), __float_as_uint(pmax), false, false); pmax = fmaxf(__uint_as_float(rr[0]), __uint_as_float(rr[1])); }
    if (!FIRST && __builtin_expect(__all(pmax <= THRL + 2.f), 1)) { alpha = 1.f; }
    else { const float d = FIRST ? pmax - 2.f : fmaxf(pmax - 2.f, 0.f); alpha = FIRST ? 0.f : __builtin_amdgcn_exp2f(-d); m_reg += d;
#pragma unroll
        for (int r = 0; r < 16; ++r) { p0[r] -= d; p1[r] -= d; negm[r] = -m_reg; } }
#pragma unroll
    for (int r = 0; r < 16; ++r) p0[r] = __builtin_amdgcn_exp2f(p0[r]);
}
__device__ __forceinline__ unsigned pk_fp8x4_ip(f32x4 v) { int w = __builtin_amdgcn_cvt_pk_fp8_f32(v[0], v[1], __builtin_bit_cast(int, v[0]), false); w = __builtin_amdgcn_cvt_pk_fp8_f32(v[2], v[3], w, true); return (unsigned)w; }
__device__ __forceinline__ v8i_t packP8(const f32x16& p0, const f32x16& p1) {
#define ATT_PK8(P, B_, LO_, HI_) do { const unsigned a_ = pk_fp8x4((f32x4){P[B_ + 0], P[B_ + 1], P[B_ + 2], P[B_ + 3]}), b_ = pk_fp8x4((f32x4){P[B_ + 4], P[B_ + 5], P[B_ + 6], P[B_ + 7]}); \
        auto r_ = __builtin_amdgcn_permlane32_swap(a_, b_, false, false); LO_ = (int)r_[0]; HI_ = (int)r_[1]; } while (0)
    v8i_t w;
#define pk_fp8x4 pk_fp8x4_ip
    ATT_PK8(p0, 0, w[0], w[1]); ATT_PK8(p0, 8, w[2], w[3]); ATT_PK8(p1, 0, w[4], w[5]); ATT_PK8(p1, 8, w[6], w[7]);
#undef pk_fp8x4
#undef ATT_PK8
    return w;
}
__device__ __forceinline__ void finishSM_exp(f32x16& p0, f32x16& p1, float alpha, float& l_reg) {
#pragma unroll
    for (int r = 0; r < 16; ++r) p1[r] = __builtin_amdgcn_exp2f(p1[r]);
    float ps = 0.f;
#pragma unroll
    for (int r = 0; r < 16; ++r) ps += p0[r];
#pragma unroll
    for (int r = 0; r < 16; ++r) ps += p1[r];
    { auto rr = __builtin_amdgcn_permlane32_swap(__float_as_uint(ps), __float_as_uint(ps), false, false); ps = __uint_as_float(rr[0]) + __uint_as_float(rr[1]); }
    l_reg = l_reg * alpha + ps;
}
__device__ __forceinline__ void packP(const f32x16& p0, const f32x16& p1, bf16x8& pa0, bf16x8& pa1, bf16x8& pa2, bf16x8& pa3) {
#define ATT_PK4(P, B_, OUT) do { const unsigned a0 = cvtpk(P[B_ + 0], P[B_ + 1]), a1 = cvtpk(P[B_ + 2], P[B_ + 3]), b0 = cvtpk(P[B_ + 4], P[B_ + 5]), b1 = cvtpk(P[B_ + 6], P[B_ + 7]); \
        auto r0 = __builtin_amdgcn_permlane32_swap(a0, b0, false, false); auto r1 = __builtin_amdgcn_permlane32_swap(a1, b1, false, false); \
        const u32x4 w_ = {r0[0], r1[0], r0[1], r1[1]}; OUT = __builtin_bit_cast(bf16x8, w_); } while (0)
    ATT_PK4(p0, 0, pa0); ATT_PK4(p0, 8, pa1); ATT_PK4(p1, 0, pa2); ATT_PK4(p1, 8, pa3);
#undef ATT_PK4
}
__device__ __forceinline__ void finishSM(f32x16& p0, f32x16& p1, float alpha, float& l_reg, bf16x8& pa0, bf16x8& pa1, bf16x8& pa2, bf16x8& pa3) {
    finishSM_exp(p0, p1, alpha, l_reg); packP(p0, p1, pa0, pa1, pa2, pa3);
}
#define LDS_RD128(dst, addr, off) asm volatile("ds_read_b128 %0, %1 offset:%2" : "=v"(dst) : "v"(addr), "i"(off) : "memory")
#define LDS_TIE1(n, x) asm volatile("s_waitcnt lgkmcnt(%1)" : "+v"(x) : "n"(n))
#define LDS_TIE2(n, x, y) asm volatile("s_waitcnt lgkmcnt(%2)" : "+v"(x), "+v"(y) : "n"(n))
struct QKRing { bf16x8 fa[3], fb[3]; };
template <int KOFF>
__device__ __forceinline__ void qkt_pre(QKRing& R, const int (&ad)[4]) {
    LDS_RD128(R.fa[0], ad[0], KOFF); LDS_RD128(R.fb[0], ad[0], KOFF + 4096); LDS_RD128(R.fa[1], ad[1], KOFF); LDS_RD128(R.fb[1], ad[1], KOFF + 4096); LDS_RD128(R.fa[2], ad[2], KOFF); LDS_RD128(R.fb[2], ad[2], KOFF + 4096);
}
template <int NSUB, int KOFF, bool CIN = false>
__device__ __forceinline__ void qkt_main(f32x16& p0, f32x16& p1, QKRing& R, const int (&ad)[4], const bf16x8* qr, const f32x16* cin = nullptr) {
    constexpr int N = 4 * NSUB;
    if constexpr (CIN) { p0 = *cin; p1 = *cin; }
    else {
#pragma unroll
        for (int e = 0; e < 16; ++e) { p0[e] = 0.f; p1[e] = 0.f; } }
#define QK_STEP(i_) do { constexpr int i = (i_); if constexpr (i < N) { \
        constexpr int ah = (N - 1 - i) < 2 ? (N - 1 - i) : 2;            \
        constexpr int na = 1 + 2 * ah, nb = 2 * ah + (i + 3 < N); \
        LDS_TIE1(na, R.fa[i % 3]); p0 = MFMA32(R.fa[i % 3], qr[i], p0); \
        if constexpr (i + 3 < N) LDS_RD128(R.fa[i % 3], ad[(i + 3) & 3], KOFF + ((i + 3) >> 2) * KSUB); \
        LDS_TIE1(nb, R.fb[i % 3]); p1 = MFMA32(R.fb[i % 3], qr[i], p1); \
        if constexpr (i + 3 < N) LDS_RD128(R.fb[i % 3], ad[(i + 3) & 3], KOFF + ((i + 3) >> 2) * KSUB + 4096); } } while (0)
    QK_STEP(0); QK_STEP(1); QK_STEP(2); QK_STEP(3); QK_STEP(4); QK_STEP(5); QK_STEP(6); QK_STEP(7); QK_STEP(8); QK_STEP(9); QK_STEP(10); QK_STEP(11);
#undef QK_STEP
}
template <int NSUB, int KOFF>
__device__ __forceinline__ void qkt(f32x16& p0, f32x16& p1, const int (&ad)[4], const bf16x8* qr) { QKRing R; qkt_pre<KOFF>(R, ad); qkt_main<NSUB, KOFF>(p0, p1, R, ad, qr); }
#define MFMA_MX(a, b, c) __builtin_amdgcn_mfma_scale_f32_32x32x64_f8f6f4((a), (b), (c), 0, 0, 0, 0x7F7F7F7F, 0, 0x7F7F7F7F)
__device__ __forceinline__ v8i_t cat8(u32x4 a, u32x4 b) { return (v8i_t){(int)a[0], (int)a[1], (int)a[2], (int)a[3], (int)b[0], (int)b[1], (int)b[2], (int)b[3]}; }
struct QKRing8 { u32x4 fa[2][2], fb[2][2]; };
#define QK8_RD(R_, slot_, s_) do { LDS_RD128(R_.fa[slot_][0], ad[0], KOFF + (s_) * KSUB); LDS_RD128(R_.fa[slot_][1], ad[1], KOFF + (s_) * KSUB); \
        LDS_RD128(R_.fb[slot_][0], ad[0], KOFF + (s_) * KSUB + 2048); LDS_RD128(R_.fb[slot_][1], ad[1], KOFF + (s_) * KSUB + 2048); } while (0)
template <int KOFF>
__device__ __forceinline__ void qkt_pre8a(QKRing8& R, const int (&ad)[2]) { QK8_RD(R, 0, 0); }
template <int KOFF>
__device__ __forceinline__ void qkt_pre8b(QKRing8& R, const int (&ad)[2]) { QK8_RD(R, 1, 1); }
template <int KOFF>
__device__ __forceinline__ void qkt_pre8(QKRing8& R, const int (&ad)[2]) { qkt_pre8a<KOFF>(R, ad); qkt_pre8b<KOFF>(R, ad); }
template <int KOFF>
__device__ __forceinline__ void qkt_main8(f32x16& p0, f32x16& p1, QKRing8& R, const int (&ad)[2], const v8i_t* q, const f32x16* cin) {
    p0 = *cin; p1 = *cin;
    LDS_TIE2(6, R.fa[0][0], R.fa[0][1]); p0 = MFMA_MX(cat8(R.fa[0][0], R.fa[0][1]), q[0], p0);
    LDS_TIE2(4, R.fb[0][0], R.fb[0][1]); p1 = MFMA_MX(cat8(R.fb[0][0], R.fb[0][1]), q[0], p1);
    QK8_RD(R, 0, 2);
    LDS_TIE2(6, R.fa[1][0], R.fa[1][1]); p0 = MFMA_MX(cat8(R.fa[1][0], R.fa[1][1]), q[1], p0);
    LDS_TIE2(4, R.fb[1][0], R.fb[1][1]); p1 = MFMA_MX(cat8(R.fb[1][0], R.fb[1][1]), q[1], p1);
    LDS_TIE2(2, R.fa[0][0], R.fa[0][1]); p0 = MFMA_MX(cat8(R.fa[0][0], R.fa[0][1]), q[2], p0);
    LDS_TIE2(0, R.fb[0][0], R.fb[0][1]); p1 = MFMA_MX(cat8(R.fb[0][0], R.fb[0][1]), q[2], p1);
}
#undef QK8_RD
template <int KPRE, typename RING, int NAD>
__device__ __forceinline__ void pv_tile_k(f32x16* o, int vb, bf16x8 pa0, bf16x8 pa1, bf16x8 pa2, bf16x8 pa3, RING& KR, const int (&ad)[NAD]) {
#define ATT_TRRD(dst, off) asm volatile("ds_read_b64_tr_b16 %0, %1 offset:%2" : "=&v"(dst) : "v"(vb), "i"(off) : "memory")
    s16x4 l[8], h[8];
#define PV_RD(j_) do { constexpr int jr = (j_); ATT_TRRD(l[jr & 7], v_rd_off(jr & 3, jr >> 2, 0)); ATT_TRRD(h[jr & 7], v_rd_off(jr & 3, jr >> 2, 1)); } while (0)
#define PV_STEP(j_, PA_) do { constexpr int j = (j_); if constexpr (j + 6 < 16) PV_RD(j + 6); \
        if constexpr (KPRE >= 0 && NAD == 4 && j == 12) qkt_pre<(KPRE >= 0 ? KPRE : 0)>(KR, ad); \
        if constexpr (KPRE >= 0 && NAD == 2 && j == 13) qkt_pre8<(KPRE >= 0 ? KPRE : 0)>(KR, ad);        \
        constexpr int n = 2 * ((15 - j) < 6 ? (15 - j) : 6) + ((KPRE >= 0 && NAD == 4 && j >= 12) ? 6 : 0) + ((KPRE >= 0 && NAD == 2 && j >= 13) ? 8 : 0); LDS_TIE2(n, l[j & 7], h[j & 7]); \
        o[j & 3] = MFMA32(PA_, ((bf16x8){l[j & 7][0], l[j & 7][1], l[j & 7][2], l[j & 7][3], h[j & 7][0], h[j & 7][1], h[j & 7][2], h[j & 7][3]}), o[j & 3]); } while (0)
    PV_RD(0); PV_RD(1); PV_RD(2); PV_RD(3); PV_RD(4); PV_RD(5);
    PV_STEP(0, pa0); PV_STEP(1, pa0); PV_STEP(2, pa0); PV_STEP(3, pa0); PV_STEP(4, pa1); PV_STEP(5, pa1); PV_STEP(6, pa1); PV_STEP(7, pa1);
    PV_STEP(8, pa2); PV_STEP(9, pa2); PV_STEP(10, pa2); PV_STEP(11, pa2); PV_STEP(12, pa3); PV_STEP(13, pa3); PV_STEP(14, pa3); PV_STEP(15, pa3);
#undef PV_STEP
#undef PV_RD
#undef ATT_TRRD
}
__device__ __forceinline__ void pv_tile(f32x16* o, int vb, bf16x8 pa0, bf16x8 pa1, bf16x8 pa2, bf16x8 pa3) { QKRing dummy; const int ad0[4] = {0, 0, 0, 0}; pv_tile_k<-1, QKRing, 4>(o, vb, pa0, pa1, pa2, pa3, dummy, ad0); }
template <int KPRE>
__device__ __forceinline__ void pv8_tile_k(f32x16* o, int vb, v8i_t pa, QKRing8& KR, const int (&ad)[2]) {
#define ATT_TRRD(dst, off) asm volatile("ds_read_b64_tr_b16 %0, %1 offset:%2" : "=&v"(dst) : "v"(vb), "i"(off) : "memory")
    u32x2 f[2][4];
#define PV8_RD(d0_) do { constexpr int dr = (d0_); ATT_TRRD(f[dr & 1][0], v_rd_off(dr, 0, 0)); ATT_TRRD(f[dr & 1][1], v_rd_off(dr, 0, 1)); ATT_TRRD(f[dr & 1][2], v_rd_off(dr, 1, 0)); ATT_TRRD(f[dr & 1][3], v_rd_off(dr, 1, 1)); } while (0)
#define PV8_MM(d0_, n_) do { constexpr int dm = (d0_); asm volatile("s_waitcnt lgkmcnt(%4)" : "+v"(f[dm & 1][0]), "+v"(f[dm & 1][1]), "+v"(f[dm & 1][2]), "+v"(f[dm & 1][3]) : "n"(n_)); \
        const v8i_t vb_ = {(int)f[dm & 1][0][0], (int)f[dm & 1][0][1], (int)f[dm & 1][1][0], (int)f[dm & 1][1][1], (int)f[dm & 1][2][0], (int)f[dm & 1][2][1], (int)f[dm & 1][3][0], (int)f[dm & 1][3][1]}; \
        o[dm] = MFMA_MX(pa, vb_, o[dm]); } while (0)
    PV8_RD(0); PV8_RD(1);
    PV8_MM(0, 4); PV8_RD(2);
    PV8_MM(1, 4); PV8_RD(3);
    if constexpr (KPRE >= 0) { qkt_pre8a<(KPRE >= 0 ? KPRE : 0)>(KR, ad); PV8_MM(2, 8); qkt_pre8b<(KPRE >= 0 ? KPRE : 0)>(KR, ad); PV8_MM(3, 8); }
    else { PV8_MM(2, 4); PV8_MM(3, 0); }
#undef PV8_MM
#undef PV8_RD
#undef ATT_TRRD
}
struct AttBlk { const unsigned char* Qp; const unsigned char* Kn; const unsigned char* Kr; const unsigned char* Vp; bf16_t* Op; const bf16_t* Zp; int P0; };
struct AttSeam { v8i_t qr[3]; int kb0, vs0; };
#define ATT_TILE0_DMA(L_, Kn_, Kr_, Vp_, kbase_, vbase_, wid_, lane_) do { \
        const int krow_ = 16 * ((wid_) & 3) + ((lane_) >> 2), kc_ = 16 * (((lane_) & 3) ^ ((krow_ >> 2) & 3)), slot_ = (lane_) & 31; \
        const int st0_ = 2 * (wid_) + ((lane_) >> 5), kk0_ = (st0_ >> 2) * 8 + (slot_ >> 2), c20_ = (st0_ & 3) * 32 + (slot_ & 3) * 8; \
        __builtin_amdgcn_global_load_lds((const unsigned*)((Kn_) + krow_ * MAIN_W + 64 * ((wid_) >> 2) + kc_), (LAS unsigned*)((L_) + (kbase_) + ((wid_) >> 2) * KSUB + ((wid_) & 3) * 1024), 16, 0, 0); \
        if ((wid_) < 4) __builtin_amdgcn_global_load_lds((const unsigned*)((Kr_) + krow_ * 64 + kc_), (LAS unsigned*)((L_) + (kbase_) + 2 * KSUB + (wid_) * 1024), 16, 0, 0); \
        __builtin_amdgcn_global_load_lds((const unsigned*)((Vp_) + kk0_ * (2 * MAIN_W) + c20_ * 2), (LAS unsigned*)((L_) + (vbase_) + (wid_) * 1024), 16, 0, 0); } while (0)
__device__ __forceinline__ void attn_prime(LAS unsigned char* L, const AttBlk& B, AttSeam& S) {
    const int tid = opaque_tid(), wid = __builtin_amdgcn_readfirstlane(tid >> 6), lane = tid & 63, r32 = lane & 31, hi = lane >> 5;
    ATT_TILE0_DMA(L, B.Kn, B.Kr, B.Vp, A_K, A_V, wid, lane);
#pragma unroll
    for (int i = 0; i < 3; ++i) { const unsigned char* qp_ = B.Qp + (size_t)(wid * 32 + r32) * NQ + 64 * i + 16 * hi; S.qr[i] = cat8(*(const u32x4*)qp_, *(const u32x4*)(qp_ + 32)); }
    S.kb0 = 0; S.vs0 = 0;
    asm volatile("s_waitcnt vmcnt(0)" ::: "memory"); __syncthreads();
}
template <int VAR>
__device__ __forceinline__ void attn_block(LAS unsigned char* L, const AttBlk& B, const AttBlk& NX, bool has_next, AttSeam& S) {
    const unsigned char* __restrict__ Kn = B.Kn; const unsigned char* __restrict__ Kr = B.Kr; const unsigned char* __restrict__ Vp = B.Vp; bf16_t* __restrict__ Op = B.Op; const bf16_t* __restrict__ Zp = B.Zp; const int P0 = B.P0;
    const int vs0 = S.vs0;
    v8i_t (&qr)[3] = S.qr;
    const int tid = opaque_tid(), wid = __builtin_amdgcn_readfirstlane(tid >> 6), lane = tid & 63, r32 = lane & 31, hi = lane >> 5;
    const bool h1 = wid >= 4;
    const int NT = (P0 + 256) / 64;
    const int qlo = P0 + wid * 32, qm = qlo + r32 - 4 * hi;
    LAS float* wsl = (LAS float*)(L + A_WS) + wid * 64;
    unsigned offKn, offKr, offV0, offV1;
    { const int krow = 16 * (wid & 3) + (lane >> 2), kc = 16 * ((lane & 3) ^ ((krow >> 2) & 3)); offKn = (unsigned)(krow * MAIN_W + kc); offKr = (unsigned)(krow * 64 + kc);
      const int slot = lane & 31;
      { const int st = 2 * (wid & 3) + (lane >> 5), kk = (st >> 2) * 8 + (slot >> 2), c2 = (st & 3) * 32 + (slot & 3) * 8; offV0 = (unsigned)(kk * (2 * MAIN_W) + c2 * 2); }
      { const int st = 2 * ((wid & 3) + 4) + (lane >> 5), kk = (st >> 2) * 8 + (slot >> 2), c2 = (st & 3) * 32 + (slot & 3) * 8; offV1 = (unsigned)(kk * (2 * MAIN_W) + c2 * 2); } }
#define ATT_DMA(gp, ldsoff) __builtin_amdgcn_global_load_lds((const unsigned*)(gp), (LAS unsigned*)(L + (ldsoff)), 16, 0, 0)
#define ATT_DMA_TILE10(t, kbuf, vbuf) do { const unsigned char* kn_ = Kn + (size_t)(t) * 64 * MAIN_W; const unsigned char* kr_ = Kr + (size_t)(t) * 64 * 64; const unsigned char* vp_ = Vp + (size_t)(t) * 64 * MAIN_W; \
        const int kd_ = A_K + (kbuf) * SHM_K + (wid & 3) * 1024, vd_ = A_V + (vbuf) * SHM_V + (wid & 3) * 1024; \
        ATT_DMA(kn_ + offKn, kd_); ATT_DMA(kn_ + offKn + 64, kd_ + KSUB); ATT_DMA(kr_ + offKr, kd_ + 2 * KSUB); ATT_DMA(vp_ + offV0, vd_); ATT_DMA(vp_ + offV1, vd_ + 4096); } while (0)
#define ATT_VMW() asm volatile("s_waitcnt vmcnt(0)" ::: "memory")
#define ATT_BAR() do { SBAR(); __builtin_amdgcn_s_barrier(); SBAR(); } while (0)
#define ATT_PIN_M() asm volatile("" : "+v"(p0), "+v"(p1), "+v"(o[0]), "+v"(o[1]), "+v"(o[2]), "+v"(o[3]))
#define ATT_PIN_V() asm volatile("" : "+v"(pa), "+v"(l_reg), "+v"(negm))
    int kb4[2];
#pragma unroll
    for (int j = 0; j < 2; ++j) kb4[j] = (int)(uintptr_t)(L + A_K) + r32 * 64 + 16 * ((2 * j + hi) ^ ((r32 >> 2) & 3));
    const int vb0 = (int)(uintptr_t)(L + A_V) + v_rd_base(lane);
    float m_reg = 0.f, l_reg = 0.f;
    f32x16 o[4], negm;
#pragma unroll
    for (int e = 0; e < 16; ++e) negm[e] = 0.f;
#pragma unroll
    for (int d = 0; d < 4; ++d)
#pragma unroll
        for (int e = 0; e < 16; ++e) o[d][e] = 0.f;
    f32x16 p0, p1; float al = 1.f; v8i_t pa; QKRing8 KR;
#define ATT_MASKT(t) do { const int kb_ = (t) * 64; if (kb_ + 63 > qlo) mask_tile(p0, p1, qm - kb_); } while (0)
#define ATT_RESC(a) do { if (__any((a) < 1.f)) { if (hi == 0) wsl[32 + r32] = (a); asm volatile("s_waitcnt lgkmcnt(0)" ::: "memory"); \
        _Pragma("unroll") for (int d_ = 0; d_ < 4; ++d_) _Pragma("unroll") for (int r = 0; r < 16; ++r) o[d_][r] *= wsl[32 + crow(r, hi)]; } } while (0)
#define ATT_SOFTMAX(t) do { ATT_MASKT(t); partialSM_rel8<false>(p0, p1, m_reg, al, negm); ATT_RESC(al); finishSM_exp(p0, p1, al, l_reg); pa = packP8(p0, p1); } while (0)
    int vprev = vs0;
    if (h1) { ATT_DMA_TILE10(1, 1, (vs0 + 1) % 3); ATT_BAR(); }
    qkt_pre8<0>(KR, kb4); qkt_main8<0>(p0, p1, KR, kb4, qr, &negm); ATT_PIN_M(); if (h1) ATT_VMW(); ATT_BAR();
    if (h1) ATT_DMA_TILE10(2, 0, (vs0 + 2) % 3);
    ATT_MASKT(0); partialSM_rel8<true>(p0, p1, m_reg, al, negm); finishSM_exp(p0, p1, al, l_reg); pa = packP8(p0, p1); ATT_PIN_V(); ATT_BAR();
#define ATT_STEP(t, PAR) do { \
        pv8_tile_k<(PAR) * SHM_K>(o, vb0 + vprev * SHM_V, pa, KR, kb4); qkt_main8<(PAR) * SHM_K>(p0, p1, KR, kb4, qr, &negm); ATT_PIN_M(); if (h1) ATT_VMW(); ATT_BAR(); \
        __builtin_amdgcn_s_setprio(1); if (h1 && (t) + 2 < NT) ATT_DMA_TILE10((t) + 2, (PAR), vprev); \
        ATT_SOFTMAX(t); ATT_PIN_V(); __builtin_amdgcn_s_setprio(0); ATT_BAR(); \
        vprev = (vprev == 2) ? 0 : vprev + 1; } while (0)
    int t = 1;
    for (; t + 1 < NT; t += 2) { ATT_STEP(t, 1); ATT_STEP(t + 1, 0); }
    ATT_STEP(t, 1);
    if (!h1) ATT_BAR();
    if (has_next) {
        { int ln_ = lane; asm volatile("" : "+v"(ln_));
          ATT_TILE0_DMA(L, NX.Kn, NX.Kr, NX.Vp, A_K, A_V + ((vs0 + NT) % 3) * SHM_V, wid, ln_); }
#pragma unroll
        for (int i = 0; i < 3; ++i) { const unsigned char* qp_ = NX.Qp + (size_t)(wid * 32 + r32) * NQ + 64 * i + 16 * hi; qr[i] = cat8(*(const u32x4*)qp_, *(const u32x4*)(qp_ + 32)); }
        S.kb0 = 0; S.vs0 = (vs0 + NT) % 3;
    }
    SBAR();
    pv8_tile_k<-1>(o, vb0 + vprev * SHM_V, pa, KR, kb4);
    {
        LAS unsigned char* stg = L + A_OST + wid * 4096;
        u32x4 zw[8];
#pragma unroll
        for (int hf = 0; hf < 2; ++hf)
#pragma unroll
            for (int i = 0; i < 4; ++i) zw[hf * 4 + i] = *(const u32x4*)(Zp + (size_t)(wid * 32 + i * 8 + (lane >> 3)) * NBP + hf * 64 + (lane & 7) * 8);
        if (hi == 0) wsl[r32] = l_reg; asm volatile("s_waitcnt lgkmcnt(0)" ::: "memory");
        float rl[16];
#pragma unroll
        for (int r = 0; r < 16; ++r) rl[r] = __builtin_amdgcn_rcpf(wsl[crow(r, hi)]);
#pragma unroll
        for (int hf = 0; hf < 2; ++hf) {
#pragma unroll
            for (int r = 0; r < 16; ++r)
#pragma unroll
                for (int d1 = 0; d1 < 2; ++d1) *(LAS bf16_t*)(stg + crow(r, hi) * 128 + (d1 * 32 + r32) * 2) = (bf16_t)(cvtpk(o[hf * 2 + d1][r] * rl[r], 0.f) & 0xffffu);
            asm volatile("s_waitcnt lgkmcnt(0)" ::: "memory"); __builtin_amdgcn_wave_barrier();
#pragma unroll
            for (int i = 0; i < 4; ++i) { const int row = i * 8 + (lane >> 3), ch = lane & 7;
                const u32x4 ov = *(const LAS u32x4*)(stg + row * 128 + ch * 16); const u32x4 z4 = zw[hf * 4 + i]; u32x4 w4;
#pragma unroll
                for (int e = 0; e < 4; ++e) w4[e] = cvtpk(bf2f(ov[e] & 0xffffu) * siluf_(bf2f(z4[e] & 0xffffu)), bf2f(ov[e] >> 16) * siluf_(bf2f(z4[e] >> 16)));
                *(u32x4*)(Op + (size_t)(wid * 32 + row) * D_MODEL + hf * 64 + ch * 8) = w4; }
            asm volatile("s_waitcnt lgkmcnt(0)" ::: "memory"); __builtin_amdgcn_wave_barrier();
        }
    }
    asm volatile("s_waitcnt vmcnt(0)" ::: "memory"); __syncthreads();
#undef ATT_DMA
#undef ATT_DMA_TILE
#undef ATT_VMW
#undef ATT_BAR
#undef ATT_PIN_M
#undef ATT_PIN_V
#undef ATT_MASKT
#undef ATT_RESC
#undef ATT_STEP
#undef ATT_SOFTMAX
#undef ATT_DMA_TILE10
}

constexpr int M_K = 0, M_V = 65536, M_WS = 131072, M_BYTES = M_WS + 2048;
__device__ __forceinline__ void memattn_load(LAS unsigned char* L, const bf16_t* __restrict__ MK, const bf16_t* __restrict__ MV) {
    const int tid = opaque_tid(), wid = __builtin_amdgcn_readfirstlane(tid >> 6), lane = tid & 63;
    const int row = 8 * wid + (lane >> 3), c = (lane & 7) ^ ((row >> 1) & 7), slot = lane & 31;
    const unsigned offK = (unsigned)(row * 2048 + c * 8);
    unsigned offV0, offV1;
    { const int st = 2 * wid + (lane >> 5), kk = (st >> 2) * 8 + (slot >> 2), key = (kk & ~0xC) | ((kk & 4) << 1) | ((kk & 8) >> 1), c2 = (st & 3) * 32 + (slot & 3) * 8; offV0 = (unsigned)(key * 2048 + c2); }
    { const int st = 2 * (wid + 8) + (lane >> 5), kk = (st >> 2) * 8 + (slot >> 2), key = (kk & ~0xC) | ((kk & 4) << 1) | ((kk & 8) >> 1), c2 = (st & 3) * 32 + (slot & 3) * 8; offV1 = (unsigned)(key * 2048 + c2); }
#pragma unroll
    for (int j = 0; j < 4; ++j) {
        const bf16_t* mk = MK + (size_t)j * 64 * 2048; const bf16_t* mv = MV + (size_t)j * 64 * 2048;
        __builtin_amdgcn_global_load_lds((const unsigned*)(mk + offK), (LAS unsigned*)(L + M_K + j * 16384 + wid * 1024), 16, 0, 0);
        __builtin_amdgcn_global_load_lds((const unsigned*)(mk + offK + 64), (LAS unsigned*)(L + M_K + j * 16384 + KSUB + wid * 1024), 16, 0, 0);
        __builtin_amdgcn_global_load_lds((const unsigned*)(mv + offV0), (LAS unsigned*)(L + M_V + j * 16384 + wid * 1024), 16, 0, 0);
        __builtin_amdgcn_global_load_lds((const unsigned*)(mv + offV1), (LAS unsigned*)(L + M_V + j * 16384 + 8192 + wid * 1024), 16, 0, 0);
    }
    asm volatile("s_waitcnt vmcnt(0)" ::: "memory"); __syncthreads();
}
__device__ __forceinline__ void memattn_tile(LAS unsigned char* L, const bf16_t* __restrict__ Qp, int ldq, bf16_t* __restrict__ Op, const bf16_t* __restrict__ Zp) {
    const int tid = opaque_tid(), wid = __builtin_amdgcn_readfirstlane(tid >> 6), lane = tid & 63, r32 = lane & 31, hi = lane >> 5;
    LAS float* wsl = (LAS float*)(L + M_WS) + wid * 64;
    bf16x8 qr[8];
#pragma unroll
    for (int d0 = 0; d0 < 8; ++d0) qr[d0] = *(const bf16x8*)(Qp + (size_t)(wid * 32 + r32) * ldq + d0 * 16 + hi * 8);
    int kb4[4];
#pragma unroll
    for (int dd = 0; dd < 4; ++dd) kb4[dd] = (int)(uintptr_t)(L + M_K) + r32 * 128 + 16 * ((2 * dd + hi) ^ ((r32 >> 1) & 7));
    const int vb0 = (int)(uintptr_t)(L + M_V) + v_rd_base(lane);
    float m_reg = -1e30f, l_reg = 0.f, alA = 1.f, alB = 1.f;
    f32x16 o[4];
#pragma unroll
    for (int d = 0; d < 4; ++d)
#pragma unroll
        for (int e = 0; e < 16; ++e) o[d][e] = 0.f;
    f32x16 pA0, pA1, pB0, pB1; bf16x8 pa0, pa1, pa2, pa3;
#define MEM_RESC(a) do { if (__any((a) < 1.f)) { if (hi == 0) wsl[32 + r32] = (a); asm volatile("s_waitcnt lgkmcnt(0)" ::: "memory"); \
        _Pragma("unroll") for (int d_ = 0; d_ < 4; ++d_) _Pragma("unroll") for (int r = 0; r < 16; ++r) o[d_][r] *= wsl[32 + crow(r, hi)]; } } while (0)
#define MEM_STEP(PX0, PX1, alX, PY0, PY1, alY, t) do { SBAR(); qkt<2, (t) * 16384>(PX0, PX1, kb4, qr); finishSM(PY0, PY1, alY, l_reg, pa0, pa1, pa2, pa3); SBAR(); \
        pv_tile(o, vb0 + ((t) - 1) * 16384, pa0, pa1, pa2, pa3); partialSM(PX0, PX1, m_reg, alX); MEM_RESC(alX); } while (0)
    qkt<2, 0>(pA0, pA1, kb4, qr); partialSM(pA0, pA1, m_reg, alA);
    MEM_STEP(pB0, pB1, alB, pA0, pA1, alA, 1); MEM_STEP(pA0, pA1, alA, pB0, pB1, alB, 2); MEM_STEP(pB0, pB1, alB, pA0, pA1, alA, 3);
    unsigned zz[16][4];
#pragma unroll
    for (int r = 0; r < 16; ++r)
#pragma unroll
        for (int d0 = 0; d0 < 4; ++d0) zz[r][d0] = Zp[(size_t)(wid * 32 + crow(r, hi)) * ldq + d0 * 32 + r32];
    finishSM(pB0, pB1, alB, l_reg, pa0, pa1, pa2, pa3); SBAR(); pv_tile(o, vb0 + 3 * 16384, pa0, pa1, pa2, pa3);
    if (hi == 0) wsl[r32] = l_reg; asm volatile("s_waitcnt lgkmcnt(0)" ::: "memory");
    unsigned pk[16][4];
#pragma unroll
    for (int r = 0; r < 16; ++r) { const float rl = __builtin_amdgcn_rcpf(wsl[crow(r, hi)]);
#pragma unroll
        for (int d0 = 0; d0 < 4; ++d0) { const float v = o[d0][r] * rl * siluf_(bf2f(zz[r][d0]));
            const float vn = __int_as_float(__builtin_amdgcn_update_dpp(0, __float_as_int(v), 0xB1, 0xF, 0xF, true));
            pk[r][d0] = cvtpk(v, vn); } }
    if ((r32 & 1) == 0) {
#pragma unroll
        for (int r = 0; r < 16; ++r)
#pragma unroll
            for (int d0 = 0; d0 < 4; ++d0) *(unsigned*)(Op + (size_t)(wid * 32 + crow(r, hi)) * D_MODEL + d0 * 32 + r32) = pk[r][d0];
    }
    asm volatile("s_waitcnt lgkmcnt(0)" ::: "memory");
#undef MEM_RESC
#undef MEM_STEP
}
__device__ __forceinline__ void memattn_phase(LAS unsigned char* L, const bf16_t* __restrict__ Hq, int ldq, int qoff, int zoff, const bf16_t* __restrict__ MEMKV, int layer, bf16_t* __restrict__ CAT, int u0, int u1) {
    int loaded = -1;
    for (int u = u0; u < 512 && u < u1; ++u) {
        const int bhd = u >> 6, tt = u & 63, b = bhd >> 2, hd = bhd & 3;
        if (bhd != loaded) { if (loaded >= 0) __syncthreads();
            const bf16_t* MK = MEMKV + (size_t)b * 256 * 2048 + layer * 1024 + hd * 128; memattn_load(L, MK, MK + 512); loaded = bhd; }
        const size_t tok0 = (size_t)b * SEQ + (size_t)tt * 256;
        memattn_tile(L, Hq + tok0 * ldq + qoff + hd * 128, ldq, CAT + tok0 * D_MODEL + MAIN_W + hd * 128, Hq + tok0 * ldq + zoff + hd * 128);
    }
    __syncthreads();
}
#undef SBAR
}


#define XB_TMO      128
#define XB_XCNT(j)  (256  + 64 * (j))
#define XB_XSUB(j)  (1280 + 64 * (j))
#define XB_XGEN(j)  (2304 + 64 * (j))
#define XB_TOP      3328
#define XB_TOPGEN   3392
#define XCD_BAR_WORDS 3456
#define XB_SPIN_CAP (1u << 20)
__device__ __forceinline__ unsigned xb_ld(unsigned* p)              { return __hip_atomic_load(p, __ATOMIC_RELAXED, __HIP_MEMORY_SCOPE_AGENT); }
__device__ __forceinline__ unsigned xb_add(unsigned* p, unsigned v) { return __hip_atomic_fetch_add(p, v, __ATOMIC_RELAXED, __HIP_MEMORY_SCOPE_AGENT); }
__device__ __forceinline__ unsigned xb_xcc_id() { return (unsigned)__builtin_amdgcn_s_getreg((3 << 11) | 20) & 0xFu; }
#define XB_SPIN(cond, bar) do { unsigned _sp = 0; while (cond) { __builtin_amdgcn_s_sleep(1); \
    if ((++_sp & 255u) == 0u) { if (xb_ld(&(bar)[XB_TMO])) break; if (_sp > XB_SPIN_CAP) { atomicAdd(&(bar)[XB_TMO], 1u); break; } } } } while (0)
struct XcdBarrier { unsigned* bar; unsigned x; volatile LAS unsigned* st; };
__device__ __forceinline__ XcdBarrier xcd_barrier_post(unsigned* bar, volatile LAS unsigned* st) {
    XcdBarrier b; b.bar = bar; b.x = xb_xcc_id(); b.st = st;
    if (threadIdx.x == 0) (void)xb_add(&bar[XB_XCNT(b.x)], 1u);
    return b;
}
__device__ __forceinline__ void xcd_barrier_complete(unsigned* bar, unsigned x, unsigned& nloc, unsigned& nx) {
    const unsigned G = gridDim.x * gridDim.y * gridDim.z;
    unsigned sum, cnt, mine, sp = 0u;
    for (;;) {
        sum = 0u; cnt = 0u; mine = 0u;
#pragma unroll
        for (unsigned j = 0; j < 16; ++j) { const unsigned c = xb_ld(&bar[XB_XCNT(j)]); sum += c; cnt += (c > 0u) ? 1u : 0u; mine = (j == x) ? c : mine; }
        if (sum == G) break;
        __builtin_amdgcn_s_sleep(1);
        if ((++sp & 255u) == 0u) { if (xb_ld(&bar[XB_TMO])) break; if (sp > XB_SPIN_CAP) { atomicAdd(&bar[XB_TMO], 1u); break; } }
    }
    nloc = mine > 0u ? mine : 1u; nx = cnt > 0u ? cnt : 1u;
}
__device__ __forceinline__ void xcd_barrier(const XcdBarrier& b) {
    asm volatile("s_waitcnt vmcnt(0)" ::: "memory");
    __syncthreads();
    if (threadIdx.x == 0) {
        unsigned* bar = b.bar;
        __builtin_amdgcn_s_waitcnt(0);
        unsigned nloc = b.st[0], nx = b.st[1];
        if (nloc == 0u) { xcd_barrier_complete(bar, b.x, nloc, nx); b.st[0] = nloc; b.st[1] = nx; }
        const unsigned old = xb_add(&bar[XB_XSUB(b.x)], 1u);
        const unsigned gen = old / nloc;
        if (old + 1u == (gen + 1u) * nloc) {
            __builtin_amdgcn_fence(__ATOMIC_RELEASE, "agent");
            asm volatile("s_waitcnt vmcnt(0)" ::: "memory");
            const unsigned og = xb_add(&bar[XB_TOP], 1u);
            const unsigned tg = og / nx;
            if (og + 1u == (tg + 1u) * nx) xb_add(&bar[XB_TOPGEN], 1u);
            else XB_SPIN(xb_ld(&bar[XB_TOPGEN]) == tg, bar);
            __builtin_amdgcn_fence(__ATOMIC_ACQUIRE, "agent");
            xb_add(&bar[XB_XGEN(b.x)], 1u);
            asm volatile("s_waitcnt vmcnt(0)" ::: "memory");
        } else {
            XB_SPIN(xb_ld(&bar[XB_XGEN(b.x)]) == gen, bar);
            __builtin_amdgcn_fence(__ATOMIC_ACQUIRE, "agent");
            asm volatile("s_waitcnt vmcnt(0)" ::: "memory");
        }
    }
    __syncthreads();
}

struct Params { const void* in[26]; float* out; unsigned char* ws; };
#ifndef DUP_PHASE
#define DUP_PHASE -1
#endif
#define REPS(k) for (int rep_ = 0; rep_ < ((DUP_PHASE == (k)) ? 2 : 1); ++rep_, (void)((DUP_PHASE == (k)) && rep_ == 1 ? (xcd_barrier(gbar), 0) : 0))

__global__ void __launch_bounds__(NT_, 2) mega(Params P) {
    extern __shared__ __attribute__((aligned(16))) unsigned char lds[];
    cg::grid_group grid = cg::this_grid();
    LAS unsigned char* L = (LAS unsigned char*)lds;
    volatile LAS unsigned* bst = (volatile LAS unsigned*)(L + LDS_BYTES - 64);
    if (threadIdx.x < 2) bst[threadIdx.x] = 0u;
    __syncthreads();
    XcdBarrier gbar = xcd_barrier_post((unsigned*)P.ws + 4096, bst);
#define GRID_BAR() xcd_barrier(gbar)
    const int nb = gridDim.x, bid = blockIdx.x, ngw = nb * 8;
    const size_t ngt = (size_t)nb * NT_;
#define IDS() const int tid = opaque_tid(), lane = tid & 63, wave = __builtin_amdgcn_readfirstlane(tid >> 6), gw = bid * 8 + wave; const size_t gt = (size_t)bid * NT_ + tid; (void)lane; (void)gw; (void)gt
    const float* x = (const float*)P.in[0]; const float* mem = (const float*)P.in[1]; const int* positions = (const int*)P.in[2];
    const float* w_in_a = (const float*)P.in[3]; const float* lam_re = (const float*)P.in[4]; const float* lam_im = (const float*)P.in[5]; const float* log_dt = (const float*)P.in[6];
    const float* b_re = (const float*)P.in[7]; const float* b_im = (const float*)P.in[8]; const float* c_re = (const float*)P.in[9]; const float* c_im = (const float*)P.in[10];
    const float* d_skip = (const float*)P.in[11]; const float* w_glu = (const float*)P.in[12]; const float* b_glu = (const float*)P.in[13];
    const float* w_in_b = (const float*)P.in[14]; const float* q_norm_g = (const float*)P.in[15]; const float* w_uq = (const float*)P.in[16]; const float* w_dkv = (const float*)P.in[17];
    const float* kv_norm_g = (const float*)P.in[18]; const float* w_kr = (const float*)P.in[19]; const float* w_uk = (const float*)P.in[20]; const float* w_uv = (const float*)P.in[21];
    const float* w_mem_kv = (const float*)P.in[22]; const float* w_out = (const float*)P.in[23]; const float* ln_g = (const float*)P.in[24]; const float* ln_b = (const float*)P.in[25];
    float* out = P.out; unsigned char* ws = P.ws; unsigned* CTL = (unsigned*)ws;
    bf16_t* WA = (bf16_t*)(ws + WS_WA); bf16_t* WGLU = (bf16_t*)(ws + WS_WGLU); bf16_t* WOUT = (bf16_t*)(ws + WS_WOUT); bf16_t* WB = (bf16_t*)(ws + WS_WB);
    bf16_t* WUKV = (bf16_t*)(ws + WS_WUKV); bf16_t* WUQ = (bf16_t*)(ws + WS_WUQ); bf16_t* WMEM = (bf16_t*)(ws + WS_WMEM); bf16_t* MEMB = (bf16_t*)(ws + WS_MEMB);
    bf16_t* MEMKV = (bf16_t*)(ws + WS_MEMKV); float* CS = (float*)(ws + WS_ROPE); float* SN = CS + (size_t)T * 32; float* RQ = (float*)(ws + WS_RQ); float* RKV = (float*)(ws + WS_RKV);
    bf16_t* XB = (bf16_t*)(ws + WS_XB); bf16_t* H = (bf16_t*)(ws + WS_H); bf16_t* G = (bf16_t*)(ws + WS_G); bf16_t* Qb = (bf16_t*)(ws + WS_G); bf16_t* CAT = (bf16_t*)(ws + WS_CAT); bf16_t* KV = (bf16_t*)(ws + WS_KV);
    bf16_t* GZ = (bf16_t*)(ws + WS_KV);
    bf16_t* Y0 = (bf16_t*)(ws + WS_H);
    bf16_t* Y1 = (bf16_t*)(ws + WS_G); bf16_t* KRb = (bf16_t*)(ws + WS_KR);
    unsigned char* Q8 = ws + WS_G; unsigned char* V8P = ws + WS_KV; unsigned char* KN8 = ws + WS_KV + (size_t)T * MAIN_W * 2; unsigned char* KR8 = ws + WS_KR;

    {
        IDS();
        int base = 0;
        LAS float* scr = (LAS float*)(L + wave * 8448);
#define WTJOB(W_, K_, Nsrc_, Wt_, roff_, nrows_, ks_, perm_) do { const int nit_ = ((nrows_) / 32) * ((K_) / 64); \
            for (int it_ = (gw - base % ngw + ngw) % ngw; it_ < nit_; it_ += ngw) wt_item_wave((W_), (K_), (Nsrc_), (Wt_), (roff_), (ks_), (perm_), it_, scr, lane); \
            base += nit_; } while (0)
        WTJOB(w_in_a, 2048, 4096, WA, 0, 4096, nullptr, 0);
        WTJOB(w_glu, 1536, 1536, WGLU, 0, 1536, nullptr, 0);
        WTJOB(w_out, 2048, 2048, WOUT, 0, 2048, nullptr, 0);
        WTJOB(w_out + (size_t)2048 * 2048, 2048, 2048, WOUT + (size_t)2048 * 2048, 0, 2048, nullptr, 0);
        WTJOB(w_in_b, 2048, 3072, WB, 0, 3072, nullptr, 0);
        WTJOB(w_dkv, 2048, 512, WB, HB_CKV, 512, nullptr, 0);
        WTJOB(w_kr, 2048, 64, WB, WB_KR, 64, nullptr, 1);
        WTJOB(w_uk, 512, 1536, WUKV, 0, 1536, kv_norm_g, 0);
        WTJOB(w_uv, 512, 1536, WUKV, 1536, 1536, kv_norm_g, 0);
        WTJOB(w_uq, 512, 2304, WUQ, 0, 2304, q_norm_g, 2);
        WTJOB(w_mem_kv, 2048, 1024, WMEM, 0, 1024, nullptr, 0);
        WTJOB(w_mem_kv + (size_t)2048 * 1024, 2048, 1024, WMEM, 1024, 1024, nullptr, 0);
#undef WTJOB
        if (bid == 0 && tid < 256) CTL[tid] = 0u;
        for (size_t i = gt; i < (size_t)T * 32; i += ngt) {
            const int row = (int)(i >> 5), j = (int)(i & 31);
            const double inv = exp2(-(double)j * (13.287712379549449 / 32.0));
            const double turns = (double)positions[row] * inv * 0.15915494309189535;
            const double fr = turns - rint(turns);
            const float a = (float)(fr * 6.283185307179586);
            CS[i] = cosf(a); SN[i] = sinf(a);
        }
        for (size_t i = gt; i < (size_t)T * D_MODEL / 4; i += 4 * ngt) {
            f32x4 v[4];
#pragma unroll
            for (int j = 0; j < 4; ++j) { const size_t ii = i + (size_t)j * ngt; v[j] = (ii < (size_t)T * D_MODEL / 4) ? __builtin_nontemporal_load((const f32x4*)x + ii) : (f32x4){0.f, 0.f, 0.f, 0.f}; }
#pragma unroll
            for (int j = 0; j < 4; ++j) { const size_t ii = i + (size_t)j * ngt; if (ii < (size_t)T * D_MODEL / 4) ((u32x2*)XB)[ii] = (u32x2){cvtpk(v[j][0], v[j][1]), cvtpk(v[j][2], v[j][3])}; }
        }
        for (size_t i = gt; i < (size_t)512 * 2048 / 4; i += ngt) { const f32x4 v = ((const f32x4*)mem)[i]; ((u32x2*)MEMB)[i] = (u32x2){pk2(v[0], v[1]), pk2(v[2], v[3])}; }
    }
    grid.sync();
    REPS(1) {
    for (int u = bid; u < 512; u += nb) skinny_unit<false>(L, MEMB, WMEM, (u >> 5) * 32, (u & 31) * 64, MEMKV, 2048, nullptr, nullptr);
    if (nb == 256) gemm_fast<EpiStore, true>(L, XB, 2048, WA, 2048, T, H_MQ, 2048, EpiStore{H, NA, 0, 0, 1.f});
    else gemm_fast<EpiStore, true>(L, XB, 2048, WA, 2048, T, NA, 2048, EpiStore{H, NA, H_MQ, H_MZ, C2_MEM});
    }
    GRID_BAR();
    REPS(2) {
    {
        IDS();
        const int xcd = bid & 7, slot = bid >> 3;
        if (nb == 256 && slot < 24) s5_unit(L, xcd * 24 + slot, H, lam_re, lam_im, log_dt, b_re, b_im, c_re, c_im, d_skip, G, GZ);
        else if (nb != 256) { for (int u = bid; u < 192; u += nb) s5_unit(L, u, H, lam_re, lam_im, log_dt, b_re, b_im, c_re, c_im, d_skip, G, GZ); }
        if (nb == 256) { if (slot >= 24) gemm_fast<EpiStore, true>(L, XB, 2048, WA + (size_t)H_MQ * 2048, 2048, T, 512, 2048, EpiStore{H + H_MQ, NA, 0, 512, C2_MEM}, 64, xcd * 8 + (slot - 24)); }
        else { const int per = (512 + nb - 1) / nb; att::memattn_phase(L, H, NA, H_MQ, H_MZ, MEMKV, 0, CAT, bid * per, (bid + 1) * per); }
    }
    }
    GRID_BAR();
    if (nb == 256) {
        gemm_fast<EpiStore, true>(L, XB, 2048, WA + (size_t)H_MZ * 2048, 2048, T, 512, 2048, EpiStore{H + H_MZ, NA, 0, 0, 1.f});
        GRID_BAR();
    }
    REPS(3) {
    gemm_fast<EpiGlu, true>(L, G, MAIN_W, WGLU, MAIN_W, T, MAIN_W, MAIN_W, EpiGlu{GZ, b_glu, CAT});
    if (nb == 256) att::memattn_phase(L, H, NA, H_MQ, H_MZ, MEMKV, 0, CAT, 2 * bid, 2 * bid + 2);
    }
    GRID_BAR();
    REPS(4) {
    gemm_fast<EpiStore, true>(L, CAT, D_MODEL, WOUT, D_MODEL, T, D_MODEL, D_MODEL, EpiStore{Y0, D_MODEL, 0, 0, 1.f});
    }
    GRID_BAR();
    REPS(5) { IDS(); for (int row = 2 * gw; row < T; row += 2 * ngw) ln_rows2<false, false>(x, Y0, nullptr, ln_g, ln_b, XB, row, lane); }
    GRID_BAR();
    REPS(6) {
    gemm_fast<EpiStore, true>(L, XB, 2048, WB, 2048, T, NBP, 2048, EpiStore{H, NBP, HB_MQ, HB_MZ, C2_MEM});
    }
    GRID_BAR();
    REPS(7) {
    { IDS();
      for (int u = bid; u < T / 32; u += nb) skinny_unit<true>(L, XB, WB + (size_t)WB_KR * 2048, u * 32, 0, KRb, 64, CS, SN);
      for (int row = gw; row < T; row += ngw) rms_row(H, RQ, RKV, row, lane); }
    }
    GRID_BAR();
    REPS(8) {
    gemm_fast<EpiKV, true>(L, H + HB_CKV, NBP, WUKV, 512, T, NKV, 512, EpiKV{KN8, V8P, RKV});
    gemm_fast<EpiQ, true>(L, H + HB_CQ, NBP, WUQ, 512, T, NQ, 512, EpiQ{Q8, RQ, CS, SN});
    if (nb == 256) { if (bid < 128) att::memattn_phase(L, H, NBP, HB_MQ, HB_MZ, MEMKV, 1, CAT, bid, bid + 1);
        else att::memattn_phase(L, H, NBP, HB_MQ, HB_MZ, MEMKV, 1, CAT, 128 + 3 * (bid - 128), 128 + 3 * (bid - 128) + 3); }
    else { const int per = (512 + nb - 1) / nb; att::memattn_phase(L, H, NBP, HB_MQ, HB_MZ, MEMKV, 1, CAT, bid * per, (bid + 1) * per); }
    }
    GRID_BAR();
#ifndef ATT_PROBE
#define ATT_PROBE 0
#endif
#define ATT_BLK(k_, B_) do { const int it_ = (nb == 256) ? (3 * (bid & 7) + ((k_) >> 1)) * 32 + (bid >> 3) : bid + ((k_) >> 1) * nb; \
        const int bh_ = it_ >> 5, xq_ = it_ & 31, b_ = bh_ / 12, hd_ = bh_ % 12, qb_ = ((k_) & 1) ? xq_ : 63 - xq_;     \
        const size_t tok0_ = (size_t)b_ * SEQ + (size_t)qb_ * 256, key0_ = (size_t)b_ * SEQ; \
        B_.Qp = Q8 + tok0_ * NQ + hd_ * 192; B_.Kn = KN8 + key0_ * MAIN_W + hd_ * 128; B_.Kr = KR8 + key0_ * 64; B_.Vp = V8P + key0_ * MAIN_W + hd_ * 256; \
        B_.Op = CAT + tok0_ * D_MODEL + hd_ * 128; B_.Zp = H + tok0_ * NBP + HB_Z + hd_ * 128; B_.P0 = qb_ * 256; } while (0)
#define ATT_PHASE(VAR_) do { const int nblk_ = 2 * ((24 * 32 - bid + nb - 1) / nb); if (nblk_ > 0) { att::AttBlk cur_, nxt_; att::AttSeam seam_; ATT_BLK(0, cur_); att::attn_prime(L, cur_, seam_); \
            _Pragma("unroll 1") for (int k_ = 0; k_ < nblk_; ++k_) { const bool hn_ = k_ + 1 < nblk_; if (hn_) ATT_BLK(k_ + 1, nxt_); else nxt_ = cur_; \
                att::attn_block<VAR_>(L, cur_, nxt_, hn_, seam_); cur_ = nxt_; } } } while (0)
    if (ATT_PROBE != 0) { ATT_PHASE(ATT_PROBE); GRID_BAR(); }
    REPS(9) { ATT_PHASE(0); }
    GRID_BAR();
    gemm_fast<EpiStore, true>(L, CAT, D_MODEL, WOUT + (size_t)2048 * 2048, D_MODEL, T, D_MODEL, D_MODEL, EpiStore{Y1, D_MODEL, 0, 0, 1.f});
    GRID_BAR();
    { IDS(); for (int row = 2 * gw; row < T; row += 2 * ngw) ln_rows2<true, true>(XB, Y1, out, ln_g + D_MODEL, ln_b + D_MODEL, nullptr, row, lane); }
}
}

extern "C" void kernel_launch(void* const* d_in, const int* in_sizes, int n_in, void* d_out, int out_size, void* d_ws, size_t ws_size, hipStream_t stream) {
    static int grid_blocks = 0;
    if (grid_blocks == 0) {
        if (n_in != 26 || in_sizes[0] != T * D_MODEL || out_size != T * D_MODEL || ws_size < WS_END) {
            fprintf(stderr, "kernel_launch: unexpected shapes (n_in %d, in0 %d, out %d, ws %zu)\n", n_in, n_in > 0 ? in_sizes[0] : -1, out_size, ws_size); grid_blocks = -1; return; }
        int dev = 0, cus = 0, per_cu = 0;
        (void)hipGetDevice(&dev);
        (void)hipDeviceGetAttribute(&cus, hipDeviceAttributeMultiprocessorCount, dev);
        (void)hipFuncSetAttribute((const void*)mega, hipFuncAttributeMaxDynamicSharedMemorySize, LDS_BYTES);
        (void)hipOccupancyMaxActiveBlocksPerMultiprocessor(&per_cu, (const void*)mega, NT_, LDS_BYTES);
        if (per_cu < 1) { fprintf(stderr, "kernel_launch: occupancy query says %d blocks per CU\n", per_cu); per_cu = 1; }
        grid_blocks = cus * per_cu;
        (void)hipGetLastError();
    }
    if (grid_blocks < 0) return;
    (void)hipMemsetAsync((char*)d_ws + 4096 * 4, 0, XCD_BAR_WORDS * 4, stream);
    Params p{};
    for (int i = 0; i < 26; ++i) p.in[i] = d_in[i];
    p.out = (float*)d_out; p.ws = (unsigned char*)d_ws;
    void* args[] = {&p};
    hipError_t e = hipLaunchCooperativeKernel((const void*)mega, dim3(grid_blocks), dim3(NT_), args, LDS_BYTES, stream);
    if (e != hipSuccess) fprintf(stderr, "cooperative launch failed: %s (grid %d)\n", hipGetErrorString(e), grid_blocks);
}
```

```cpp
#include <hip/hip_runtime.h>
#include <hip/hip_cooperative_groups.h>
#include <stdint.h>
#include <stdio.h>

namespace cg = cooperative_groups;
namespace {
typedef unsigned short bf16_t;
typedef short bf16x8 __attribute__((ext_vector_type(8)));
typedef float f32x4 __attribute__((ext_vector_type(4)));
typedef float f32x16 __attribute__((ext_vector_type(16)));
typedef unsigned u32x2 __attribute__((ext_vector_type(2)));
typedef unsigned u32x4 __attribute__((ext_vector_type(4)));
typedef int v8i_t __attribute__((ext_vector_type(8)));

constexpr int D_MODEL = 2048, BATCH = 2, SEQ = 16384, T = BATCH * SEQ;
constexpr int MAIN_W = 1536, MEM_W = 512;
constexpr int NA = 4096;
constexpr int NBP = 3584;
constexpr int HB_CQ = 0, HB_Z = 512, HB_MQ = 2048, HB_MZ = 2560, HB_CKV = 3072, WB_KR = 3584;
constexpr int KRS = 64;
constexpr int H_U = 0, H_Z = 1536, H_MQ = 3072, H_MZ = 3584;
constexpr int NKV = 3072;
constexpr int NQ = 2304;
constexpr float ALPHA = 1.4142135623730951f;
constexpr float LN_EPS = 1e-5f, RMS_EPS = 1e-6f;
constexpr float LOG2E = 1.4426950408889634f;
constexpr float C2_MLA = 0.07216878364870322f * LOG2E;
constexpr float C2_MEM = 0.08838834764831845f * LOG2E;

constexpr size_t MiB = 1u << 20;
constexpr size_t WS_WA = 1 * MiB;
constexpr size_t WS_WGLU = 17 * MiB;
constexpr size_t WS_WOUT = 22 * MiB;
constexpr size_t WS_WB = 38 * MiB;
constexpr size_t WS_WUKV = 53 * MiB;
constexpr size_t WS_WUQ = 56 * MiB;
constexpr size_t WS_WMEM = 59 * MiB;
constexpr size_t WS_MEMB = 67 * MiB;
constexpr size_t WS_MEMKV = 69 * MiB;
constexpr size_t WS_ROPE = 71 * MiB;
constexpr size_t WS_RQ = 79 * MiB;
constexpr size_t WS_RKV = 80 * MiB;
constexpr size_t WS_KR = 84 * MiB;
constexpr size_t WS_XB = 96 * MiB;
constexpr size_t WS_H = 224 * MiB;
constexpr size_t WS_G = 480 * MiB;
constexpr size_t WS_CAT = 624 * MiB;
constexpr size_t WS_KV = 752 * MiB;
constexpr size_t WS_END = 944 * MiB;

__device__ __forceinline__ unsigned f2bf(float f) { unsigned u = __float_as_uint(f); return (u + 0x7fffu + ((u >> 16) & 1u)) >> 16; }
__device__ __forceinline__ float bf2f(unsigned b) { return __uint_as_float(b << 16); }
__device__ __forceinline__ unsigned pk2(float lo, float hi) { return f2bf(lo) | (f2bf(hi) << 16); }
__device__ __forceinline__ int crow(int r, int h) { return (r & 3) + 8 * (r >> 2) + 4 * h; }
__device__ __forceinline__ float sigmoidf_(float v) { return __builtin_amdgcn_rcpf(1.f + __builtin_amdgcn_exp2f(-1.4426950408889634f * v)); }
__device__ __forceinline__ float siluf_(float v) { return v * sigmoidf_(v); }
__device__ __forceinline__ float gelu_tanh(float y) { return y * sigmoidf_(1.5957691216057308f * y * (1.f + 0.044715f * y * y)); }
#define MFMA32(a, b, c) __builtin_amdgcn_mfma_f32_32x32x16_bf16((a), (b), (c), 0, 0, 0)


constexpr int NT_ = 512;
constexpr int LDS_BYTES = 147456;
#define LAS __attribute__((address_space(3)))
__device__ __forceinline__ int opaque_tid() { int t = threadIdx.x; asm volatile("" : "+v"(t)); return t; }
__device__ __forceinline__ float shfl_idx(float v, int srclane) { return __int_as_float(__builtin_amdgcn_ds_bpermute(srclane << 2, __float_as_int(v))); }

__device__ __forceinline__ int perm_src(int n, int perm) {
    if (perm == 1) return (n & 1) ? 32 + (n >> 1) : (n >> 1);
    if (perm == 2) { const int j = n % 192; if (j < 128) return n; const int jj = j - 128; return n - j + 128 + ((jj & 1) ? 32 + (jj >> 1) : (jj >> 1)); }
    return n;
}
__device__ __forceinline__ void wt_item_wave(const float* __restrict__ W, int K, int Nsrc, bf16_t* __restrict__ Wt, int row_off, const float* __restrict__ ks, int perm, int item, LAS float* scr, int lane) {
    const int nblk = K / 64, n0 = (item / nblk) * 32, k0 = (item % nblk) * 64;
    const int srcn = perm_src(n0 + (lane & 31), perm);
#pragma unroll 8
    for (int i = 0; i < 32; ++i) { const int kk = 2 * i + (lane >> 5); float v = W[(size_t)(k0 + kk) * Nsrc + srcn]; if (ks) v *= ks[k0 + kk]; scr[kk * 33 + (lane & 31)] = v; }
    asm volatile("s_waitcnt lgkmcnt(0)" ::: "memory"); __builtin_amdgcn_wave_barrier();
    const int c = lane & 7;
#pragma unroll
    for (int j = 0; j < 4; ++j) { const int n = (lane >> 3) + 8 * j; const LAS float* sp = scr + (8 * c) * 33 + n;
        const u32x4 o = {pk2(sp[0], sp[33]), pk2(sp[2 * 33], sp[3 * 33]), pk2(sp[4 * 33], sp[5 * 33]), pk2(sp[6 * 33], sp[7 * 33])};
        *(u32x4*)(Wt + (size_t)(row_off + n0 + n) * K + k0 + 8 * c) = o; }
    asm volatile("s_waitcnt lgkmcnt(0)" ::: "memory"); __builtin_amdgcn_wave_barrier();
}

__device__ __forceinline__ void st_bf16x4(bf16_t* p, f32x4 v) { *(u32x2*)p = (u32x2){pk2(v[0], v[1]), pk2(v[2], v[3])}; }
__device__ __forceinline__ unsigned cvtpk_(float lo, float hi) { typedef float f2_ __attribute__((ext_vector_type(2))); typedef __bf16 b2_ __attribute__((ext_vector_type(2))); const f2_ v = {lo, hi}; const b2_ b = __builtin_convertvector(v, b2_); return __builtin_bit_cast(unsigned, b); }
__device__ __forceinline__ void st_bf16x8(bf16_t* p, f32x4 a, f32x4 b) { *(u32x4*)p = (u32x4){cvtpk_(a[0], a[1]), cvtpk_(a[2], a[3]), cvtpk_(b[0], b[1]), cvtpk_(b[2], b[3])}; }
struct EpiStore {
    bf16_t* O; int ldc; int s_lo, s_hi; float sc;
    __device__ __forceinline__ void apply4(int row, int col, f32x4 v) const { if (col >= s_lo && col < s_hi) v = v * sc; st_bf16x4(O + (size_t)row * ldc + col, v); }
    __device__ __forceinline__ void apply8(int row, int col, f32x4 a, f32x4 b) const { if (col >= s_lo && col < s_hi) { a = a * sc; b = b * sc; } st_bf16x8(O + (size_t)row * ldc + col, a, b); }
};
struct EpiGlu {
    const bf16_t* GZ; const float* bias; bf16_t* CAT;
    __device__ __forceinline__ void apply4(int row, int col, f32x4 v) const {
        const u32x2 gw = *(const u32x2*)(GZ + (size_t)row * MAIN_W + col); const f32x4 bv = *(const f32x4*)(bias + col);
        const float g[4] = {bf2f(gw[0] & 0xffffu), bf2f(gw[0] >> 16), bf2f(gw[1] & 0xffffu), bf2f(gw[1] >> 16)};
        f32x4 o;
#pragma unroll
        for (int i = 0; i < 4; ++i) o[i] = g[i] * sigmoidf_(v[i] + bv[i]);
        st_bf16x4(CAT + (size_t)row * D_MODEL + col, o);
    }
    __device__ __forceinline__ void apply8(int row, int col, f32x4 a, f32x4 b) const {
        const u32x4 gw = *(const u32x4*)(GZ + (size_t)row * MAIN_W + col); const f32x4 b0 = *(const f32x4*)(bias + col), b1 = *(const f32x4*)(bias + col + 4);
        f32x4 oa, ob;
#pragma unroll
        for (int i = 0; i < 2; ++i) { oa[2 * i] = bf2f(gw[i] & 0xffffu) * sigmoidf_(a[2 * i] + b0[2 * i]); oa[2 * i + 1] = bf2f(gw[i] >> 16) * sigmoidf_(a[2 * i + 1] + b0[2 * i + 1]);
                                      ob[2 * i] = bf2f(gw[2 + i] & 0xffffu) * sigmoidf_(b[2 * i] + b1[2 * i]); ob[2 * i + 1] = bf2f(gw[2 + i] >> 16) * sigmoidf_(b[2 * i + 1] + b1[2 * i + 1]); }
        st_bf16x8(CAT + (size_t)row * D_MODEL + col, oa, ob);
    }
};
__device__ __forceinline__ unsigned pk_fp8x4(f32x4 v) { int w = __builtin_amdgcn_cvt_pk_fp8_f32(v[0], v[1], 0, false); w = __builtin_amdgcn_cvt_pk_fp8_f32(v[2], v[3], w, true); return (unsigned)w; }
struct EpiKV {
    unsigned char* KN8; unsigned char* V8P; const float* rkv;
    __device__ __forceinline__ void apply4(int, int, f32x4) const {}
    __device__ __forceinline__ void apply8(int row, int col, f32x4 a, f32x4 b) const { const float r = rkv[row];
        if (col < MAIN_W) { const float r4 = r * 0.25f; *(u32x2*)(KN8 + (size_t)row * MAIN_W + col) = (u32x2){pk_fp8x4(a * r4), pk_fp8x4(b * r4)}; }
        else { const unsigned w0 = pk_fp8x4(a * r), w1 = pk_fp8x4(b * r);
            const bool odd = (row & 1) != 0;
            const unsigned give = odd ? w0 : w1;
            const unsigned got = (unsigned)__builtin_amdgcn_update_dpp(0, (int)give, 0xB1, 0xF, 0xF, true);
            const unsigned ev = odd ? got : w0, od = odd ? w1 : got;
            const u32x2 o = {__builtin_amdgcn_perm(od, ev, 0x05010400u), __builtin_amdgcn_perm(od, ev, 0x07030602u)};
            *(u32x2*)(V8P + (size_t)(row >> 1) * (2 * MAIN_W) + (size_t)(col - MAIN_W + (odd ? 4 : 0)) * 2) = o; }
    }
};
__device__ __forceinline__ f32x4 rope4(f32x4 v, const float* cs, const float* sn, int idx) {
    const float c0 = cs[idx], s0 = sn[idx], c1 = cs[idx + 1], s1 = sn[idx + 1];
    return (f32x4){v[0] * c0 - v[1] * s0, v[1] * c0 + v[0] * s0, v[2] * c1 - v[3] * s1, v[3] * c1 + v[2] * s1};
}
struct EpiQ {
    unsigned char* Q; const float* rq; const float* cs; const float* sn;
    __device__ __forceinline__ void apply4(int row, int col, f32x4 v) const {
        v = v * (rq[row] * (C2_MLA * 4.f));
        const int j = col % 192;
        if (j >= 128) v = rope4(v, cs, sn, row * 32 + ((j - 128) >> 1));
        *(unsigned*)(Q + (size_t)row * NQ + col) = pk_fp8x4(v);
    }
    __device__ __forceinline__ void apply8(int row, int col, f32x4 a, f32x4 b) const {
        const float sc = rq[row] * (C2_MLA * 4.f); a = a * sc; b = b * sc;
        const int j = col % 192;
        if (j >= 128) { a = rope4(a, cs, sn, row * 32 + ((j - 128) >> 1)); b = rope4(b, cs, sn, row * 32 + ((j - 124) >> 1)); }
        *(u32x2*)(Q + (size_t)row * NQ + col) = (u32x2){pk_fp8x4(a), pk_fp8x4(b)};
    }
};


namespace pg8 {
constexpr int BM = 256, BK = 64, HALF = 128, HTB = HALF * BK * 2, STAGE_BYTES = 8 * HTB, NXCD = 8, WGM = 8;
__host__ __device__ __forceinline__ int lds_byte(int r, int c) { const int st = (r >> 4) * 2 + (c >> 5), rr = r & 15, cc = c & 31, ob = rr * 64 + cc * 2; return st * 1024 + (ob ^ (((ob >> 9) & 1) << 5)); }
__host__ __device__ __forceinline__ void stage_rc(int b, int& R, int& C) { const int st = b / 1024, sb = b % 1024, swz = sb ^ (((sb >> 9) & 1) << 5); R = (st >> 1) * 16 + swz / 64; C = (st & 1) * 32 + (swz % 64) / 2; }
__host__ __device__ __forceinline__ int perm32(int rho) { const int n = rho >> 4, i = rho & 15; return 8 * (i >> 2) + 4 * n + (i & 3); }
struct Unit { int pm, pn; };
struct Gemm { const bf16_t* A; const bf16_t* Bt; int M, N, K, lda, ldb; };
struct StaticOrder {
    int nM, nN, nwg, G, c;
    __device__ void init(int M, int N, int G_, int c_) { nM = M / BM; nN = N / BM; nwg = nM * nN; G = G_; c = c_; }
    __device__ bool next(int i, Unit& u) const {
        const long L = (long)i * G + c; if (L >= nwg) return false;
        int wgid = (int)L; { const int q = nwg / NXCD, r = nwg % NXCD, xcd = wgid % NXCD, off = wgid / NXCD; wgid = (xcd < r ? xcd * (q + 1) : r * (q + 1) + (xcd - r) * q) + off; }
        const int nig = WGM * nN, gid = wgid / nig, fm = gid * WGM, gsz = (nM - fm) < WGM ? (nM - fm) : WGM;
        u.pm = fm + ((wgid % nig) % gsz); u.pn = (wgid % nig) / gsz; return true;
    }
};
template <class Epi, bool ALIGN_EPI, bool SP2>
__device__ __forceinline__ void gemm_phase(LAS unsigned char* lds, const Gemm g, const StaticOrder& S, const Epi& E) {
    const int tid = opaque_tid(), wid = __builtin_amdgcn_readfirstlane(tid >> 6), lane = tid & 63, wr = wid >> 2, wc = wid & 3, fr = lane & 15, fq = lane >> 4;
    const int K = g.K, nt = K / BK;
    unsigned voffA[2], voffB[2];
#pragma unroll
    for (int i = 0; i < 2; ++i) { int R, C; stage_rc(tid * 16 + i * 8192, R, C); const int Rb = Epi::PERM ? ((R & ~31) + perm32(R & 31)) : R;
        voffA[i] = (unsigned)(R * g.lda + C) * 2u; voffB[i] = (unsigned)(Rb * g.ldb + C) * 2u; }
    const size_t kstep = (size_t)(BK * 2);
    const size_t hsA = (size_t)HALF * g.lda * 2, hsB = (size_t)HALF * g.ldb * 2;
    const size_t tsA = 2 * hsA, tsB = 2 * hsB;
    const unsigned ldsw = (unsigned)wid * 1024u;
    const int aoff = lds_byte(wr * 64 + fr, fq * 8), boff = lds_byte(wc * 32 + fr, fq * 8);
#define PG8_SA(b, h) (((b) * 2 + (h)) * HTB)
#define PG8_SB(b, h) ((4 + (b) * 2 + (h)) * HTB)
#define PG8_STAGE(bufoff, gbase, voff) do { _Pragma("unroll") for (int _i = 0; _i < 2; ++_i) \
        __builtin_amdgcn_global_load_lds((const unsigned*)((const char*)(gbase) + (voff)[_i]), (LAS unsigned*)(lds + (bufoff) + ldsw + _i * 8192), 16, 0, 0); } while (0)
#define PG8_LDA(dst, b, h) do { _Pragma("unroll") for (int m = 0; m < 4; ++m) _Pragma("unroll") for (int k = 0; k < 2; ++k) dst[m][k] = *(const LAS bf16x8*)(lds + PG8_SA(b, h) + aoff + m * 2048 + k * 1024); } while (0)
#define PG8_LDB(dst, b, h) do { _Pragma("unroll") for (int n = 0; n < 2; ++n) _Pragma("unroll") for (int k = 0; k < 2; ++k) dst[n][k] = *(const LAS bf16x8*)(lds + PG8_SB(b, h) + boff + n * 2048 + k * 1024); } while (0)
#define PG8_MMA(ai, bj, At, Bt) do { __builtin_amdgcn_s_setprio(1); _Pragma("unroll") for (int m = 0; m < 4; ++m) _Pragma("unroll") for (int n = 0; n < 2; ++n) _Pragma("unroll") for (int k = 0; k < 2; ++k) \
        acc[ai][bj][m][n] = __builtin_amdgcn_mfma_f32_16x16x32_bf16(Bt[n][k], At[m][k], acc[ai][bj][m][n], 0, 0, 0); __builtin_amdgcn_s_setprio(0); } while (0)
#define PG8_WAIT_V(n) asm volatile("s_waitcnt vmcnt(" #n ")" ::: "memory")
#define PG8_WAIT_L(n) asm volatile("s_waitcnt lgkmcnt(" #n ")" ::: "memory")
#define PG8_BAR __builtin_amdgcn_s_barrier()
#define PG8_SCHED __builtin_amdgcn_sched_barrier(0)
    Unit cur, nxt; int ui = 0;
    if (!S.next(0, cur)) return;
    f32x4 acc[2][2][4][2];
#pragma unroll
    for (int a = 0; a < 2; ++a)
#pragma unroll
        for (int b = 0; b < 2; ++b)
#pragma unroll
            for (int m = 0; m < 4; ++m)
#pragma unroll
                for (int n = 0; n < 2; ++n) acc[a][b][m][n] = (f32x4){0.f, 0.f, 0.f, 0.f};
    bf16x8 At[4][2], B0[2][2], B1[2][2];
    const char* cA = (const char*)g.A + (size_t)cur.pm * tsA; const char* cB = (const char*)g.Bt + (size_t)cur.pn * tsB;
    if constexpr (SP2) {
        PG8_STAGE(PG8_SB(0, 0), cB, voffB); PG8_STAGE(PG8_SB(0, 1), cB + hsB, voffB); PG8_STAGE(PG8_SA(0, 0), cA, voffA); PG8_STAGE(PG8_SA(0, 1), cA + hsA, voffA);
        if (wr == 1) PG8_BAR;
        PG8_WAIT_V(2); PG8_BAR;
        PG8_STAGE(PG8_SB(1, 0), cB + kstep, voffB); PG8_STAGE(PG8_SA(1, 0), cA + kstep, voffA); PG8_STAGE(PG8_SB(1, 1), cB + hsB + kstep, voffB);
        PG8_WAIT_V(6); PG8_BAR;
    } else {
        PG8_STAGE(PG8_SB(0, 0), cB, voffB); PG8_STAGE(PG8_SA(0, 0), cA, voffA); PG8_STAGE(PG8_SB(0, 1), cB + hsB, voffB); PG8_STAGE(PG8_SA(0, 1), cA + hsA, voffA);
        if (wr == 1) PG8_BAR;
        PG8_WAIT_V(4); PG8_BAR;
        PG8_STAGE(PG8_SB(1, 0), cB + kstep, voffB); PG8_STAGE(PG8_SA(1, 0), cA + kstep, voffA); PG8_STAGE(PG8_SB(1, 1), cB + hsB + kstep, voffB);
        PG8_WAIT_V(6); PG8_BAR;
    }
    for (;;) {
        const bool has_next = S.next(ui + 1, nxt);
        const char* nA = has_next ? (const char*)g.A + (size_t)nxt.pm * tsA : cA; const char* nB = has_next ? (const char*)g.Bt + (size_t)nxt.pn * tsB : cB;
        for (int t = 0; t < nt; t += 2) {
            const bool last = (t == nt - 2);
            const char* a1 = cA + (size_t)(t + 1) * kstep;
            const char* a2 = last ? nA : cA + (size_t)(t + 2) * kstep; const char* b2 = last ? nB : cB + (size_t)(t + 2) * kstep;
            const char* a3 = a2 + kstep; const char* b3 = b2 + kstep;
            if constexpr (SP2) {
            PG8_LDB(B0, 0, 0); PG8_LDB(B1, 0, 1); PG8_SCHED; PG8_LDA(At, 0, 0); PG8_STAGE(PG8_SA(1, 1), a1 + hsA, voffA);
            PG8_WAIT_V(8); PG8_WAIT_L(0); PG8_BAR; PG8_MMA(0, 0, At, B0); PG8_MMA(0, 1, At, B1); PG8_BAR; PG8_SCHED;
            PG8_LDA(At, 0, 1); PG8_STAGE(PG8_SB(0, 0), b2, voffB); PG8_STAGE(PG8_SB(0, 1), b2 + hsB, voffB); PG8_STAGE(PG8_SA(0, 0), a2, voffA);
            PG8_WAIT_V(8); PG8_WAIT_L(0); PG8_BAR; PG8_MMA(1, 0, At, B0); PG8_MMA(1, 1, At, B1); PG8_BAR; PG8_SCHED;
            PG8_LDB(B0, 1, 0); PG8_LDB(B1, 1, 1); PG8_SCHED; PG8_LDA(At, 1, 0); PG8_STAGE(PG8_SA(0, 1), a2 + hsA, voffA);
            PG8_WAIT_V(8); PG8_WAIT_L(0); PG8_BAR; PG8_MMA(0, 0, At, B0); PG8_MMA(0, 1, At, B1); PG8_BAR; PG8_SCHED;
            PG8_LDA(At, 1, 1); PG8_STAGE(PG8_SB(1, 0), b3, voffB); PG8_STAGE(PG8_SB(1, 1), b3 + hsB, voffB); PG8_STAGE(PG8_SA(1, 0), a3, voffA);
            PG8_WAIT_V(8); PG8_WAIT_L(0); PG8_BAR; PG8_MMA(1, 0, At, B0); PG8_MMA(1, 1, At, B1); PG8_BAR; PG8_SCHED;
            } else {
            PG8_LDB(B0, 0, 0); PG8_SCHED; PG8_LDA(At, 0, 0); PG8_STAGE(PG8_SA(1, 1), a1 + hsA, voffA);
            PG8_WAIT_L(8); PG8_BAR; PG8_WAIT_L(0); PG8_MMA(0, 0, At, B0); PG8_BAR; PG8_SCHED;
            PG8_LDB(B1, 0, 1); PG8_STAGE(PG8_SB(0, 0), b2, voffB);
            PG8_BAR; PG8_WAIT_L(0); PG8_MMA(0, 1, At, B1); PG8_BAR;
            PG8_LDA(At, 0, 1); PG8_STAGE(PG8_SA(0, 0), a2, voffA);
            PG8_BAR; PG8_WAIT_L(0); PG8_MMA(1, 0, At, B0); PG8_BAR; PG8_SCHED;
            PG8_STAGE(PG8_SB(0, 1), b2 + hsB, voffB);
            PG8_WAIT_V(6); PG8_BAR; PG8_MMA(1, 1, At, B1); PG8_BAR;
            PG8_LDB(B0, 1, 0); PG8_SCHED; PG8_LDA(At, 1, 0); PG8_STAGE(PG8_SA(0, 1), a2 + hsA, voffA);
            PG8_WAIT_L(8); PG8_BAR; PG8_WAIT_L(0); PG8_MMA(0, 0, At, B0); PG8_BAR; PG8_SCHED;
            PG8_LDB(B1, 1, 1); PG8_STAGE(PG8_SB(1, 0), b3, voffB);
            PG8_BAR; PG8_WAIT_L(0); PG8_MMA(0, 1, At, B1); PG8_BAR;
            PG8_LDA(At, 1, 1); PG8_STAGE(PG8_SA(1, 0), a3, voffA);
            PG8_BAR; PG8_WAIT_L(0); PG8_MMA(1, 0, At, B0); PG8_BAR; PG8_SCHED;
            PG8_STAGE(PG8_SB(1, 1), b3 + hsB, voffB);
            PG8_WAIT_V(6); PG8_BAR; PG8_MMA(1, 1, At, B1); PG8_BAR;
            }
        }
        if constexpr (ALIGN_EPI) { if (wr == 0) PG8_BAR; }
        E(acc, cur, wr, wc, fr, fq);
        if (!has_next) break;
#pragma unroll
        for (int a = 0; a < 2; ++a)
#pragma unroll
            for (int b = 0; b < 2; ++b)
#pragma unroll
                for (int m = 0; m < 4; ++m)
#pragma unroll
                    for (int n = 0; n < 2; ++n) acc[a][b][m][n] = (f32x4){0.f, 0.f, 0.f, 0.f};
        cur = nxt; cA = nA; cB = nB; ++ui;
        if constexpr (ALIGN_EPI) { if (wr == 1) PG8_BAR; }
    }
    PG8_WAIT_V(0);
    if constexpr (!ALIGN_EPI) { if (wr == 0) PG8_BAR; }
    PG8_BAR;
#undef PG8_SA
#undef PG8_SB
#undef PG8_STAGE
#undef PG8_LDA
#undef PG8_LDB
#undef PG8_MMA
#undef PG8_WAIT_V
#undef PG8_WAIT_L
#undef PG8_BAR
#undef PG8_SCHED
}
}
template <class E4, bool PERM_> struct EpiA {
    static constexpr bool PERM = PERM_; E4 e;
    __device__ __forceinline__ void operator()(const f32x4 (&acc)[2][2][4][2], const pg8::Unit& u, int wr, int wc, int fr, int fq) const {
#pragma unroll
        for (int ai = 0; ai < 2; ++ai)
#pragma unroll
            for (int m = 0; m < 4; ++m) { const int row = u.pm * 256 + ai * 128 + wr * 64 + m * 16 + fr;
#pragma unroll
                for (int bj = 0; bj < 2; ++bj) { const int cb = u.pn * 256 + bj * 128 + wc * 32;
                    if (PERM_) { e.apply8(row, cb + 8 * fq, acc[ai][bj][m][0], acc[ai][bj][m][1]); }
                    else { e.apply4(row, cb + 4 * fq, acc[ai][bj][m][0]); e.apply4(row, cb + 16 + 4 * fq, acc[ai][bj][m][1]); } } }
    }
};
template <class E4, bool PERM_>
__device__ __forceinline__ void gemm_fast(LAS unsigned char* lds, const bf16_t* A, int lda, const bf16_t* Bt, int ldb, int M, int N, int K, const E4& e, int G = -1, int c = -1) {
    pg8::StaticOrder S; S.init(M, N, G > 0 ? G : (int)gridDim.x, G > 0 ? c : (int)blockIdx.x);
    const pg8::Gemm g{A, Bt, M, N, K, lda, ldb};
    const EpiA<E4, PERM_> E{e};
    pg8::gemm_phase<EpiA<E4, PERM_>, true, true>(lds, g, S, E);
}

__device__ __forceinline__ float wave_sum(float v, int lane) {
#pragma unroll
    for (int o = 1; o < 64; o <<= 1) v += shfl_idx(v, lane ^ o);
    return v;
}
__device__ __forceinline__ void rms_row(const bf16_t* __restrict__ HB, float* __restrict__ rq, float* __restrict__ rkv, int row, int lane) {
    const u32x4 a = *(const u32x4*)(HB + (size_t)row * NBP + HB_CQ + lane * 8), b = *(const u32x4*)(HB + (size_t)row * NBP + HB_CKV + lane * 8);
    float sa = 0.f, sb = 0.f;
#pragma unroll
    for (int i = 0; i < 4; ++i) { float x = bf2f(a[i] & 0xffffu), y = bf2f(a[i] >> 16); sa += x * x + y * y; x = bf2f(b[i] & 0xffffu); y = bf2f(b[i] >> 16); sb += x * x + y * y; }
    sa = wave_sum(sa, lane); sb = wave_sum(sb, lane);
    if (lane == 0) { rq[row] = 1.f / sqrtf(sa * (1.f / 512.f) + RMS_EPS); rkv[row] = 1.f / sqrtf(sb * (1.f / 512.f) + RMS_EPS); }
}
template <bool XBF, bool OUTF>
__device__ __forceinline__ void ln_rows2(const void* __restrict__ xin, const bf16_t* __restrict__ Y, float* __restrict__ out, const float* __restrict__ g, const float* __restrict__ b, bf16_t* __restrict__ XB, int row0, int lane) {
    f32x4 v[2][8]; float s[2] = {0.f, 0.f};
#pragma unroll
    for (int k = 0; k < 2; ++k) { const u32x2* yr = (const u32x2*)(Y + (size_t)(row0 + k) * D_MODEL) + lane;
#pragma unroll
        for (int j = 0; j < 8; ++j) { f32x4 xv;
            if (XBF) { const u32x2 xw = __builtin_nontemporal_load((const u32x2*)((const bf16_t*)xin + (size_t)(row0 + k) * D_MODEL) + lane + 64 * j); xv = (f32x4){bf2f(xw[0] & 0xffffu), bf2f(xw[0] >> 16), bf2f(xw[1] & 0xffffu), bf2f(xw[1] >> 16)}; }
            else xv = __builtin_nontemporal_load((const f32x4*)((const float*)xin + (size_t)(row0 + k) * D_MODEL) + lane + 64 * j);
            const u32x2 yw = __builtin_nontemporal_load(yr + 64 * j);
            v[k][j] = xv * ALPHA + (f32x4){bf2f(yw[0] & 0xffffu), bf2f(yw[0] >> 16), bf2f(yw[1] & 0xffffu), bf2f(yw[1] >> 16)}; } }
#pragma unroll
    for (int k = 0; k < 2; ++k)
#pragma unroll
        for (int j = 0; j < 8; ++j) s[k] += (v[k][j][0] + v[k][j][1]) + (v[k][j][2] + v[k][j][3]);
#pragma unroll
    for (int o = 1; o < 64; o <<= 1) { s[0] += shfl_idx(s[0], lane ^ o); s[1] += shfl_idx(s[1], lane ^ o); }
    float s2[2] = {0.f, 0.f};
#pragma unroll
    for (int k = 0; k < 2; ++k) { const float mean = s[k] * (1.f / D_MODEL);
#pragma unroll
        for (int j = 0; j < 8; ++j) { v[k][j] = v[k][j] - mean; s2[k] += (v[k][j][0] * v[k][j][0] + v[k][j][1] * v[k][j][1]) + (v[k][j][2] * v[k][j][2] + v[k][j][3] * v[k][j][3]); } }
#pragma unroll
    for (int o = 1; o < 64; o <<= 1) { s2[0] += shfl_idx(s2[0], lane ^ o); s2[1] += shfl_idx(s2[1], lane ^ o); }
#pragma unroll
    for (int k = 0; k < 2; ++k) { const float rstd = 1.f / sqrtf(s2[k] * (1.f / D_MODEL) + LN_EPS);
#pragma unroll
        for (int j = 0; j < 8; ++j) { const int c = (64 * j + lane) * 4; const f32x4 gg = *(const f32x4*)(g + c), bb = *(const f32x4*)(b + c);
            const f32x4 o = v[k][j] * rstd * gg + bb;
            if (OUTF) __builtin_nontemporal_store(o, (f32x4*)(out + (size_t)(row0 + k) * D_MODEL) + lane + 64 * j);
            if (XB) *(u32x2*)(XB + (size_t)(row0 + k) * D_MODEL + c) = (u32x2){cvtpk_(o[0], o[1]), cvtpk_(o[2], o[3])}; } }
}
template <bool ROPE>
__device__ __forceinline__ void skinny_unit(LAS unsigned char* L, const bf16_t* __restrict__ A, const bf16_t* __restrict__ Wt, int m0, int n0, bf16_t* __restrict__ C, int ldc, const float* __restrict__ cs, const float* __restrict__ sn) {
    const int tid = opaque_tid(), w = __builtin_amdgcn_readfirstlane(tid >> 6), lane = tid & 63, r = lane & 31, h = lane >> 5;
    f32x16 acc0, acc1;
#pragma unroll
    for (int e = 0; e < 16; ++e) { acc0[e] = 0.f; acc1[e] = 0.f; }
    const bf16_t* a0 = A + (size_t)(m0 + r) * D_MODEL + w * 256 + 8 * h; const bf16_t* b0 = Wt + (size_t)(n0 + r) * D_MODEL + w * 256 + 8 * h; const bf16_t* b1 = b0 + (size_t)32 * D_MODEL;
#pragma unroll
    for (int k = 0; k < 256; k += 16) { const bf16x8 fa = *(const bf16x8*)(a0 + k), fb0 = *(const bf16x8*)(b0 + k), fb1 = *(const bf16x8*)(b1 + k);
        acc0 = MFMA32(fb0, fa, acc0); acc1 = MFMA32(fb1, fa, acc1); }
    LAS float* red = (LAS float*)L;
#pragma unroll
    for (int e = 0; e < 16; ++e) { red[w * 2048 + e * 64 + lane] = acc0[e]; red[w * 2048 + (16 + e) * 64 + lane] = acc1[e]; }
    __syncthreads();
    {
        const int m = tid & 31, cg = tid >> 5, tile = cg >> 3, q = cg & 7, hh = q & 1, e0 = 4 * (q >> 1);
        f32x4 v = {0.f, 0.f, 0.f, 0.f};
#pragma unroll
        for (int w2 = 0; w2 < 8; ++w2)
#pragma unroll
            for (int j = 0; j < 4; ++j) v[j] += red[w2 * 2048 + (tile * 16 + e0 + j) * 64 + hh * 32 + m];
        const int row = m0 + m, col = 4 * cg;
        if (ROPE) { v = rope4(v, cs, sn, row * 32 + (col >> 1)); *(unsigned*)((unsigned char*)C + (size_t)row * ldc + n0 + col) = pk_fp8x4(v * 0.25f); }
        else st_bf16x4(C + (size_t)row * ldc + n0 + col, v);
    }
    __syncthreads();
}

constexpr int S5_BB = 0, S5_CF = 4096, S5_AT = 12288, S5_A64 = 12800, S5_A2K = 13312, S5_PWC = 13824, S5_EW = 14336, S5_W = 18432, S5_A8 = S5_W + 32768, S5_BYTES = S5_A8 + 512;
typedef float f32x2 __attribute__((ext_vector_type(2)));
typedef __bf16 bf16x2_t __attribute__((ext_vector_type(2)));
__device__ __forceinline__ unsigned cvtpk(float lo, float hi) { const f32x2 v = {lo, hi}; const bf16x2_t b = __builtin_convertvector(v, bf16x2_t); return __builtin_bit_cast(unsigned, b); }
__device__ __forceinline__ f32x2 cmul(f32x2 a, f32x2 b) { return (f32x2){a.x * b.x - a.y * b.y, a.x * b.y + a.y * b.x}; }
#define S5_PIDX(t_, q_) (16 * (t_) + ((q_) & 1) + 4 * ((q_) >> 1) + 2 * hh)
#define S5_STEP(UB_, BB_) do { _Pragma("unroll") for (int t_ = 0; t_ < 4; ++t_) { _Pragma("unroll") for (int q_ = 0; q_ < 8; ++q_) { const float xr_ = X[t_][2 * q_], xi_ = X[t_][2 * q_ + 1]; \
            float a_ = Ar[t_][q_].x * xr_, b_ = Ar[t_][q_].x * xi_; asm("" : "+v"(a_), "+v"(b_)); \
            a_ = fmaf(-Ar[t_][q_].y, xi_, a_); b_ = fmaf(Ar[t_][q_].y, xr_, b_); asm("" : "+v"(a_), "+v"(b_)); X[t_][2 * q_] = a_; X[t_][2 * q_ + 1] = b_; } \
            X[t_] = MFMA32(BB_(t_), (UB_), X[t_]); } } while (0)
#define S5_BB_REG(t_) bbf[t_]
#define S5_BB_LDS(t_) (*(const volatile LAS bf16x8*)(L + S5_BB + ((t_) * 64 + lane) * 16))
__device__ __forceinline__ void s5_unit(LAS unsigned char* L, int unit, const bf16_t* __restrict__ H, const float* __restrict__ lam_re, const float* __restrict__ lam_im, const float* __restrict__ log_dt,
                                        const float* __restrict__ b_re, const float* __restrict__ b_im, const float* __restrict__ c_re, const float* __restrict__ c_im,
                                        const float* __restrict__ d_skip, bf16_t* __restrict__ G, bf16_t* __restrict__ GZ) {
    const int tid = opaque_tid(), lane = tid & 63, w = __builtin_amdgcn_readfirstlane(tid >> 6), col = lane & 31, hh = lane >> 5;
    const int b = unit / 96, g = unit % 96;
    if (tid < 64) {
        const int p = tid, tau = p >> 4, i = p & 15;
        const float dt = expf(log_dt[g]), lr = lam_re[g * 64 + p], li = lam_im[g * 64 + p];
        const float mag = expf(lr * dt), a_re = mag * cosf(li * dt), a_im = mag * sinf(li * dt);
        const float den = lr * lr + li * li, n_re = a_re - 1.f, n_im = a_im;
        const float cf_re = (n_re * lr + n_im * li) / den, cf_im = (n_im * lr - n_re * li) / den;
        ((LAS f32x2*)(L + S5_AT))[p] = (f32x2){a_re, a_im};
        { f32x2 m = {a_re, a_im};
#pragma unroll
          for (int i2 = 0; i2 < 6; ++i2) m = cmul(m, m);
          ((LAS f32x2*)(L + S5_A64))[p] = m;
          { f32x2 m8 = {a_re, a_im}; m8 = cmul(m8, m8); m8 = cmul(m8, m8); m8 = cmul(m8, m8); ((LAS f32x2*)(L + S5_A8))[p] = m8; }
#pragma unroll
          for (int i2 = 0; i2 < 5; ++i2) m = cmul(m, m);
          ((LAS f32x2*)(L + S5_A2K))[p] = m;
          const double tq = 64.0 * (double)li * (double)dt * 0.15915494309189535;
          ((LAS f32x2*)(L + S5_PWC))[p] = (f32x2){64.f * lr * dt * LOG2E, (float)(tq - floor(tq))}; }
#pragma unroll
        for (int h2 = 0; h2 < 2; ++h2) {
            u32x4 wr_, wi_;
#pragma unroll
            for (int j = 0; j < 4; ++j) {
                const float br0 = b_re[(g * 64 + p) * 16 + 8 * h2 + 2 * j], bi0 = b_im[(g * 64 + p) * 16 + 8 * h2 + 2 * j], br1 = b_re[(g * 64 + p) * 16 + 8 * h2 + 2 * j + 1], bi1 = b_im[(g * 64 + p) * 16 + 8 * h2 + 2 * j + 1];
                wr_[j] = cvtpk(cf_re * br0 - cf_im * bi0, cf_re * br1 - cf_im * bi1); wi_[j] = cvtpk(cf_re * bi0 + cf_im * br0, cf_re * bi1 + cf_im * br1); }
            *(LAS u32x4*)(L + S5_BB + (tau * 64 + h2 * 32 + 2 * i) * 16) = wr_;
            *(LAS u32x4*)(L + S5_BB + (tau * 64 + h2 * 32 + 2 * i + 1) * 16) = wi_;
            f32x2 ak = {1.f, 0.f};
#pragma unroll 1
            for (int k = 0; k < 8; ++k) { u32x4 vr_, vi_;
#pragma unroll
                for (int j = 0; j < 4; ++j) {
                    const float br0 = b_re[(g * 64 + p) * 16 + 8 * h2 + 2 * j], bi0 = b_im[(g * 64 + p) * 16 + 8 * h2 + 2 * j], br1 = b_re[(g * 64 + p) * 16 + 8 * h2 + 2 * j + 1], bi1 = b_im[(g * 64 + p) * 16 + 8 * h2 + 2 * j + 1];
                    const float Br0 = cf_re * br0 - cf_im * bi0, Bi0 = cf_re * bi0 + cf_im * br0, Br1 = cf_re * br1 - cf_im * bi1, Bi1 = cf_re * bi1 + cf_im * br1;
                    vr_[j] = cvtpk(ak.x * Br0 - ak.y * Bi0, ak.x * Br1 - ak.y * Bi1); vi_[j] = cvtpk(ak.x * Bi0 + ak.y * Br0, ak.x * Bi1 + ak.y * Br1); }
                *(LAS u32x4*)(L + S5_W + ((k * 4 + tau) * 64 + h2 * 32 + 2 * i) * 16) = vr_;
                *(LAS u32x4*)(L + S5_W + ((k * 4 + tau) * 64 + h2 * 32 + 2 * i + 1) * 16) = vi_;
                ak = cmul(ak, (f32x2){a_re, a_im}); }
        }
    }
    {
        const int f = tid >> 6, tau = f >> 1, kk = f & 1, rho = lane & 31, h2 = lane >> 5;
        const int hq = rho >> 2, hp = (hq == 1) ? rho + 4 : (hq == 2) ? rho - 4 : rho;
        float v[8];
#pragma unroll
        for (int j = 0; j < 8; ++j) { const int row = 16 * kk + 8 * (j >> 2) + 4 * h2 + (j & 3), p = 16 * tau + (row >> 1);
            float c = 0.f; if (rho < 16) c = (row & 1) ? -c_im[(g * 16 + hp) * 64 + p] : c_re[(g * 16 + hp) * 64 + p]; v[j] = c; }
        *(LAS u32x4*)(L + S5_CF + (f * 64 + lane) * 16) = (u32x4){cvtpk(v[0], v[1]), cvtpk(v[2], v[3]), cvtpk(v[4], v[5]), cvtpk(v[6], v[7])};
    }
    __syncthreads();
    const size_t row0 = (size_t)b * SEQ + (size_t)(32 * w + col) * 64;
    const bf16_t* up = H + row0 * NA + H_U + g * 16 + 8 * hh;
    f32x16 X[4];
#pragma unroll
    for (int t = 0; t < 4; ++t)
#pragma unroll
        for (int e = 0; e < 16; ++e) X[t][e] = 0.f;
    {
        f32x2 Ar[4][8];
#pragma unroll
        for (int t = 0; t < 4; ++t)
#pragma unroll
            for (int q = 0; q < 8; ++q) Ar[t][q] = ((const LAS f32x2*)(L + S5_A8))[S5_PIDX(t, q)];
#define S5_ROT() do { _Pragma("unroll") for (int t_ = 0; t_ < 4; ++t_) { _Pragma("unroll") for (int q_ = 0; q_ < 8; ++q_) { const float xr_ = X[t_][2 * q_], xi_ = X[t_][2 * q_ + 1]; \
            float a_ = Ar[t_][q_].x * xr_, b_ = Ar[t_][q_].x * xi_; asm("" : "+v"(a_), "+v"(b_)); \
            a_ = fmaf(-Ar[t_][q_].y, xi_, a_); b_ = fmaf(Ar[t_][q_].y, xr_, b_); asm("" : "+v"(a_), "+v"(b_)); X[t_][2 * q_] = a_; X[t_][2 * q_ + 1] = b_; } } } while (0)
#define S5_WF(k_, t_) (*(const volatile LAS bf16x8*)(L + S5_W + (((k_) * 4 + (t_)) * 64 + lane) * 16))
#define S5_ACC4(UB_, k_) do { _Pragma("unroll") for (int t_ = 0; t_ < 4; ++t_) X[t_] = MFMA32(S5_WF(k_, t_), (UB_), X[t_]); } while (0)
        bf16x8 ub[4], un[4];
#pragma unroll
        for (int i = 0; i < 4; ++i) ub[i] = *(const bf16x8*)(up + (size_t)i * NA);
#pragma unroll 1
        for (int s0 = 0; s0 < 64; s0 += 8) {
#pragma unroll
            for (int i = 0; i < 4; ++i) un[i] = *(const bf16x8*)(up + (size_t)(s0 + 4 + i) * NA);
            if (s0 != 0) S5_ROT();
            S5_ACC4(ub[0], 7); S5_ACC4(ub[1], 6); S5_ACC4(ub[2], 5); S5_ACC4(ub[3], 4); __builtin_amdgcn_sched_barrier(0);
            const int sn = (s0 + 8 < 64) ? s0 + 8 : s0;
#pragma unroll
            for (int i = 0; i < 4; ++i) ub[i] = *(const bf16x8*)(up + (size_t)(sn + i) * NA);
            S5_ACC4(un[0], 3); S5_ACC4(un[1], 2); S5_ACC4(un[2], 1); S5_ACC4(un[3], 0); __builtin_amdgcn_sched_barrier(0);
        }
#undef S5_ACC4
#undef S5_WF
#undef S5_ROT
    }
#define S5_SCAN_HALF(t_, q0_) do { f32x2 Mk[4]; _Pragma("unroll") for (int q = 0; q < 4; ++q) Mk[q] = ((const LAS f32x2*)(L + S5_A64))[S5_PIDX(t_, (q0_) + q)]; \
        _Pragma("unroll") for (int k = 0; k < 5; ++k) { const int d = 1 << k; const bool ok = col >= d; const int src = (lane - d) & 63; \
            _Pragma("unroll") for (int q = 0; q < 4; ++q) { const int e_ = 2 * ((q0_) + q); float sr = shfl_idx(X[t_][e_], src), si = shfl_idx(X[t_][e_ + 1], src); sr = ok ? sr : 0.f; si = ok ? si : 0.f; \
                X[t_][e_] += Mk[q].x * sr - Mk[q].y * si; X[t_][e_ + 1] += Mk[q].x * si + Mk[q].y * sr; if (k < 4) Mk[q] = cmul(Mk[q], Mk[q]); } } \
        if (col == 31) { _Pragma("unroll") for (int q = 0; q < 4; ++q) ((LAS f32x2*)(L + S5_EW))[w * 64 + S5_PIDX(t_, (q0_) + q)] = (f32x2){X[t_][2 * ((q0_) + q)], X[t_][2 * ((q0_) + q) + 1]}; } \
        __builtin_amdgcn_sched_barrier(0); } while (0)
    S5_SCAN_HALF(0, 0); S5_SCAN_HALF(0, 4); S5_SCAN_HALF(1, 0); S5_SCAN_HALF(1, 4); S5_SCAN_HALF(2, 0); S5_SCAN_HALF(2, 4); S5_SCAN_HALF(3, 0); S5_SCAN_HALF(3, 4);
    __syncthreads();
#define S5_CARRY_HALF(t_, q0_) do { f32x2 gin[4]; _Pragma("unroll") for (int q = 0; q < 4; ++q) gin[q] = (f32x2){0.f, 0.f}; \
        for (int w2 = 0; w2 < w; ++w2) { _Pragma("unroll") for (int q = 0; q < 4; ++q) { const f32x2 m = ((const LAS f32x2*)(L + S5_A2K))[S5_PIDX(t_, (q0_) + q)]; \
            const f32x2 e = ((const LAS f32x2*)(L + S5_EW))[w2 * 64 + S5_PIDX(t_, (q0_) + q)]; gin[q] = cmul(m, gin[q]) + e; } } \
        const int srcp = (lane - 1) & 63; const bool okp = col >= 1; float pr[4], pi[4]; \
        _Pragma("unroll") for (int q = 0; q < 4; ++q) { pr[q] = shfl_idx(X[t_][2 * ((q0_) + q)], srcp); pi[q] = shfl_idx(X[t_][2 * ((q0_) + q) + 1], srcp); } \
        _Pragma("unroll") for (int q = 0; q < 4; ++q) { const f32x2 pc = ((const LAS f32x2*)(L + S5_PWC))[S5_PIDX(t_, (q0_) + q)]; \
            const float tr = (float)col * pc.y, fr = tr - floorf(tr), mg = __builtin_amdgcn_exp2f((float)col * pc.x); \
            const f32x2 pw = {mg * __builtin_amdgcn_cosf(fr), mg * __builtin_amdgcn_sinf(fr)}; const f32x2 c = cmul(pw, gin[q]); \
            X[t_][2 * ((q0_) + q)] = (okp ? pr[q] : 0.f) + c.x; X[t_][2 * ((q0_) + q) + 1] = (okp ? pi[q] : 0.f) + c.y; } \
        __builtin_amdgcn_sched_barrier(0); } while (0)
    S5_CARRY_HALF(0, 0); S5_CARRY_HALF(0, 4); S5_CARRY_HALF(1, 0); S5_CARRY_HALF(1, 4); S5_CARRY_HALF(2, 0); S5_CARRY_HALF(2, 4); S5_CARRY_HALF(3, 0); S5_CARRY_HALF(3, 4);
    {
        f32x2 Ar[4][8];
#pragma unroll
        for (int t = 0; t < 4; ++t)
#pragma unroll
            for (int q = 0; q < 8; ++q) Ar[t][q] = ((const volatile LAS f32x2*)(L + S5_AT))[S5_PIDX(t, q)];
        float dsk[8];
#pragma unroll
        for (int e = 0; e < 8; ++e) dsk[e] = d_skip[g * 16 + 8 * hh + e];
        bf16_t* gp = G + row0 * MAIN_W + g * 16 + 8 * hh; bf16_t* gzp = GZ + row0 * MAIN_W + g * 16 + 8 * hh;
        const bf16_t* zp = up + (H_Z - H_U);
        bf16x8 ub[2], un[2], zb[2], zn[2];
#pragma unroll
        for (int i = 0; i < 2; ++i) { ub[i] = *(const bf16x8*)(up + (size_t)i * NA); zb[i] = *(const bf16x8*)(zp + (size_t)i * NA); }
#pragma unroll 1
        for (int s0 = 0; s0 < 64; s0 += 2) {
            const int sn = (s0 + 2 < 64) ? s0 + 2 : s0;
#pragma unroll
            for (int i = 0; i < 2; ++i) { un[i] = *(const bf16x8*)(up + (size_t)(sn + i) * NA); zn[i] = *(const bf16x8*)(zp + (size_t)(sn + i) * NA); }
#pragma unroll
            for (int i = 0; i < 2; ++i) {
                S5_STEP(ub[i], S5_BB_LDS); __builtin_amdgcn_sched_barrier(0);
                f32x16 Y;
#pragma unroll
                for (int e = 0; e < 16; ++e) Y[e] = 0.f;
#pragma unroll
                for (int t = 0; t < 4; ++t)
#pragma unroll
                    for (int kk = 0; kk < 2; ++kk) {
                        const u32x4 pw = {cvtpk(X[t][8 * kk], X[t][8 * kk + 1]), cvtpk(X[t][8 * kk + 2], X[t][8 * kk + 3]), cvtpk(X[t][8 * kk + 4], X[t][8 * kk + 5]), cvtpk(X[t][8 * kk + 6], X[t][8 * kk + 7])};
                        const bf16x8 cf = *(const volatile LAS bf16x8*)(L + S5_CF + ((t * 2 + kk) * 64 + lane) * 16);
                        Y = MFMA32(cf, __builtin_bit_cast(bf16x8, pw), Y);
                    }
                const u32x4 uw = __builtin_bit_cast(u32x4, ub[i]), zw = __builtin_bit_cast(u32x4, zb[i]);
                float gl[8], gz[8];
#pragma unroll
                for (int e = 0; e < 4; ++e) {
                    gl[2 * e] = gelu_tanh(Y[2 * e] + dsk[2 * e] * bf2f(uw[e] & 0xffffu)); gl[2 * e + 1] = gelu_tanh(Y[2 * e + 1] + dsk[2 * e + 1] * bf2f(uw[e] >> 16));
                    gz[2 * e] = gl[2 * e] * siluf_(bf2f(zw[e] & 0xffffu)); gz[2 * e + 1] = gl[2 * e + 1] * siluf_(bf2f(zw[e] >> 16)); }
                *(u32x4*)(gp + (size_t)(s0 + i) * MAIN_W) = (u32x4){cvtpk(gl[0], gl[1]), cvtpk(gl[2], gl[3]), cvtpk(gl[4], gl[5]), cvtpk(gl[6], gl[7])};
                *(u32x4*)(gzp + (size_t)(s0 + i) * MAIN_W) = (u32x4){cvtpk(gz[0], gz[1]), cvtpk(gz[2], gz[3]), cvtpk(gz[4], gz[5]), cvtpk(gz[6], gz[7])};
                __builtin_amdgcn_sched_barrier(0);
            }
#pragma unroll
            for (int i = 0; i < 2; ++i) { ub[i] = un[i]; zb[i] = zn[i]; }
        }
    }
    __syncthreads();
}


namespace att {
constexpr int KSUB = 8192, SHM_K = 3 * KSUB, SHM_V = 16384, A_K = 0, A_V = 2 * SHM_K, A_WS = A_V + 3 * SHM_V, A_OST = A_WS + 2048, A_BYTES = A_OST + 8 * 4096;
constexpr float THRL = 6.f;
typedef short s16x4 __attribute__((ext_vector_type(4)));
#define SBAR() __builtin_amdgcn_sched_barrier(0)
__device__ __forceinline__ int v_rd_base(int lane) { return ((lane & 3) << 3) | (((lane >> 2) & 3) << 6) | (((lane >> 4) & 1) << 5) | (((lane >> 5) & 1) << 8); }
constexpr int v_rd_off(int d0, int ks, int half) { return d0 * 512 + ks * 4096 + half * 2048; }
__device__ __forceinline__ void mask_tile(f32x16& p0, f32x16& p1, int dq) {
    const float NEG = -__builtin_inff();
#pragma unroll
    for (int r = 0; r < 16; ++r) { const int c = (r & 3) + 8 * (r >> 2); if (dq - c < 0) p0[r] = NEG; if (dq - c - 32 < 0) p1[r] = NEG; }
}
__device__ __forceinline__ void partialSM(f32x16& p0, f32x16& p1, float& m_reg, float& alpha) {
    float pmax = p0[0];
#pragma unroll
    for (int r = 1; r < 16; ++r) pmax = fmaxf(pmax, p0[r]);
#pragma unroll
    for (int r = 0; r < 16; ++r) pmax = fmaxf(pmax, p1[r]);
    { auto rr = __builtin_amdgcn_permlane32_swap(__float_as_uint(pmax), __float_as_uint(pmax), false, false); pmax = fmaxf(__uint_as_float(rr[0]), __uint_as_float(rr[1])); }
    float mn;
    if (__builtin_expect(__all(pmax - m_reg <= THRL), 1)) { mn = m_reg; alpha = 1.f; }
    else { mn = fmaxf(m_reg, pmax); alpha = __builtin_amdgcn_exp2f(m_reg - mn); m_reg = mn; }
#pragma unroll
    for (int r = 0; r < 16; ++r) { p0[r] -= mn; p1[r] -= mn; }
#pragma unroll
    for (int r = 0; r < 16; ++r) p0[r] = __builtin_amdgcn_exp2f(p0[r]);
}
template <bool FIRST>
__device__ __forceinline__ void partialSM_rel(f32x16& p0, f32x16& p1, float& m_reg, float& alpha, f32x16& negm) {
    float pmax = p0[0];
#pragma unroll
    for (int r = 1; r < 16; ++r) pmax = fmaxf(pmax, p0[r]);
#pragma unroll
    for (int r = 0; r < 16; ++r) pmax = fmaxf(pmax, p1[r]);
    { auto rr = __builtin_amdgcn_permlane32_swap(__float_as_uint(pmax), __float_as_uint(pmax), false, false); pmax = fmaxf(__uint_as_float(rr[0]), __uint_as_float(rr[1])); }
    if (!FIRST && __builtin_expect(__all(pmax <= THRL), 1)) { alpha = 1.f; }
    else { const float d = FIRST ? pmax : fmaxf(pmax, 0.f); alpha = FIRST ? 0.f : __builtin_amdgcn_exp2f(-d); m_reg += d;
#pragma unroll
        for (int r = 0; r < 16; ++r) { p0[r] -= d; p1[r] -= d; negm[r] = -m_reg; } }
#pragma unroll
    for (int r = 0; r < 16; ++r) p0[r] = __builtin_amdgcn_exp2f(p0[r]);
}
template <bool FIRST>
__device__ __forceinline__ void partialSM_rel8(f32x16& p0, f32x16& p1, float& m_reg, float& alpha, f32x16& negm) {
    float pmax = p0[0];
#pragma unroll
    for (int r = 1; r < 16; ++r) pmax = fmaxf(pmax, p0[r]);
#pragma unroll
    for (int r = 0; r < 16; ++r) pmax = fmaxf(pmax, p1[r]);
    { auto rr = __builtin_amdgcn_permlane32_swap(__float_as_uint(pmax), __float_as_uint(pmax), false, false); pmax = fmaxf(__uint_as_float(rr[0]), __uint_as_float(rr[1])); }
    if (!FIRST && __builtin_expect(__all(pmax <= THRL + 2.f), 1)) { alpha = 1.f; }
    else { const float d = FIRST ? pmax - 2.f : fmaxf(pmax - 2.f, 0.f); alpha = FIRST ? 0.f : __builtin_amdgcn_exp2f(-d); m_reg += d;
#pragma unroll
        for (int r = 0; r < 16; ++r) { p0[r] -= d; p1[r] -= d; negm[r] = -m_reg; } }
#pragma unroll
    for (int r = 0; r < 16; ++r) p0[r] = __builtin_amdgcn_exp2f(p0[r]);
}
__device__ __forceinline__ unsigned pk_fp8x4_ip(f32x4 v) { int w = __builtin_amdgcn_cvt_pk_fp8_f32(v[0], v[1], __builtin_bit_cast(int, v[0]), false); w = __builtin_amdgcn_cvt_pk_fp8_f32(v[2], v[3], w, true); return (unsigned)w; }
__device__ __forceinline__ v8i_t packP8(const f32x16& p0, const f32x16& p1) {
#define ATT_PK8(P, B_, LO_, HI_) do { const unsigned a_ = pk_fp8x4((f32x4){P[B_ + 0], P[B_ + 1], P[B_ + 2], P[B_ + 3]}), b_ = pk_fp8x4((f32x4){P[B_ + 4], P[B_ + 5], P[B_ + 6], P[B_ + 7]}); \
        auto r_ = __builtin_amdgcn_permlane32_swap(a_, b_, false, false); LO_ = (int)r_[0]; HI_ = (int)r_[1]; } while (0)
    v8i_t w;
#define pk_fp8x4 pk_fp8x4_ip
    ATT_PK8(p0, 0, w[0], w[1]); ATT_PK8(p0, 8, w[2], w[3]); ATT_PK8(p1, 0, w[4], w[5]); ATT_PK8(p1, 8, w[6], w[7]);
#undef pk_fp8x4
#undef ATT_PK8
    return w;
}
__device__ __forceinline__ void finishSM_exp(f32x16& p0, f32x16& p1, float alpha, float& l_reg) {
#pragma unroll
    for (int r = 0; r < 16; ++r) p1[r] = __builtin_amdgcn_exp2f(p1[r]);
    float ps = 0.f;
#pragma unroll
    for (int r = 0; r < 16; ++r) ps += p0[r];
#pragma unroll
    for (int r = 0; r < 16; ++r) ps += p1[r];
    { auto rr = __builtin_amdgcn_permlane32_swap(__float_as_uint(ps), __float_as_uint(ps), false, false); ps = __uint_as_float(rr[0]) + __uint_as_float(rr[1]); }
    l_reg = l_reg * alpha + ps;
}
__device__ __forceinline__ void packP(const f32x16& p0, const f32x16& p1, bf16x8& pa0, bf16x8& pa1, bf16x8& pa2, bf16x8& pa3) {
#define ATT_PK4(P, B_, OUT) do { const unsigned a0 = cvtpk(P[B_ + 0], P[B_ + 1]), a1 = cvtpk(P[B_ + 2], P[B_ + 3]), b0 = cvtpk(P[B_ + 4], P[B_ + 5]), b1 = cvtpk(P[B_ + 6], P[B_ + 7]); \
        auto r0 = __builtin_amdgcn_permlane32_swap(a0, b0, false, false); auto r1 = __builtin_amdgcn_permlane32_swap(a1, b1, false, false); \
        const u32x4 w_ = {r0[0], r1[0], r0[1], r1[1]}; OUT = __builtin_bit_cast(bf16x8, w_); } while (0)
    ATT_PK4(p0, 0, pa0); ATT_PK4(p0, 8, pa1); ATT_PK4(p1, 0, pa2); ATT_PK4(p1, 8, pa3);
#undef ATT_PK4
}
__device__ __forceinline__ void finishSM(f32x16& p0, f32x16& p1, float alpha, float& l_reg, bf16x8& pa0, bf16x8& pa1, bf16x8& pa2, bf16x8& pa3) {
    finishSM_exp(p0, p1, alpha, l_reg); packP(p0, p1, pa0, pa1, pa2, pa3);
}
#define LDS_RD128(dst, addr, off) asm volatile("ds_read_b128 %0, %1 offset:%2" : "=v"(dst) : "v"(addr), "i"(off) : "memory")
#define LDS_TIE1(n, x) asm volatile("s_waitcnt lgkmcnt(%1)" : "+v"(x) : "n"(n))
#define LDS_TIE2(n, x, y) asm volatile("s_waitcnt lgkmcnt(%2)" : "+v"(x), "+v"(y) : "n"(n))
struct QKRing { bf16x8 fa[3], fb[3]; };
template <int KOFF>
__device__ __forceinline__ void qkt_pre(QKRing& R, const int (&ad)[4]) {
    LDS_RD128(R.fa[0], ad[0], KOFF); LDS_RD128(R.fb[0], ad[0], KOFF + 4096); LDS_RD128(R.fa[1], ad[1], KOFF); LDS_RD128(R.fb[1], ad[1], KOFF + 4096); LDS_RD128(R.fa[2], ad[2], KOFF); LDS_RD128(R.fb[2], ad[2], KOFF + 4096);
}
template <int NSUB, int KOFF, bool CIN = false>
__device__ __forceinline__ void qkt_main(f32x16& p0, f32x16& p1, QKRing& R, const int (&ad)[4], const bf16x8* qr, const f32x16* cin = nullptr) {
    constexpr int N = 4 * NSUB;
    if constexpr (CIN) { p0 = *cin; p1 = *cin; }
    else {
#pragma unroll
        for (int e = 0; e < 16; ++e) { p0[e] = 0.f; p1[e] = 0.f; } }
#define QK_STEP(i_) do { constexpr int i = (i_); if constexpr (i < N) { \
        constexpr int ah = (N - 1 - i) < 2 ? (N - 1 - i) : 2;            \
        constexpr int na = 1 + 2 * ah, nb = 2 * ah + (i + 3 < N); \
        LDS_TIE1(na, R.fa[i % 3]); p0 = MFMA32(R.fa[i % 3], qr[i], p0); \
        if constexpr (i + 3 < N) LDS_RD128(R.fa[i % 3], ad[(i + 3) & 3], KOFF + ((i + 3) >> 2) * KSUB); \
        LDS_TIE1(nb, R.fb[i % 3]); p1 = MFMA32(R.fb[i % 3], qr[i], p1); \
        if constexpr (i + 3 < N) LDS_RD128(R.fb[i % 3], ad[(i + 3) & 3], KOFF + ((i + 3) >> 2) * KSUB + 4096); } } while (0)
    QK_STEP(0); QK_STEP(1); QK_STEP(2); QK_STEP(3); QK_STEP(4); QK_STEP(5); QK_STEP(6); QK_STEP(7); QK_STEP(8); QK_STEP(9); QK_STEP(10); QK_STEP(11);
#undef QK_STEP
}
template <int NSUB, int KOFF>
__device__ __forceinline__ void qkt(f32x16& p0, f32x16& p1, const int (&ad)[4], const bf16x8* qr) { QKRing R; qkt_pre<KOFF>(R, ad); qkt_main<NSUB, KOFF>(p0, p1, R, ad, qr); }
#define MFMA_MX(a, b, c) __builtin_amdgcn_mfma_scale_f32_32x32x64_f8f6f4((a), (b), (c), 0, 0, 0, 0x7F7F7F7F, 0, 0x7F7F7F7F)
__device__ __forceinline__ v8i_t cat8(u32x4 a, u32x4 b) { return (v8i_t){(int)a[0], (int)a[1], (int)a[2], (int)a[3], (int)b[0], (int)b[1], (int)b[2], (int)b[3]}; }
struct QKRing8 { u32x4 fa[2][2], fb[2][2]; };
#define QK8_RD(R_, slot_, s_) do { LDS_RD128(R_.fa[slot_][0], ad[0], KOFF + (s_) * KSUB); LDS_RD128(R_.fa[slot_][1], ad[1], KOFF + (s_) * KSUB); \
        LDS_RD128(R_.fb[slot_][0], ad[0], KOFF + (s_) * KSUB + 2048); LDS_RD128(R_.fb[slot_][1], ad[1], KOFF + (s_) * KSUB + 2048); } while (0)
template <int KOFF>
__device__ __forceinline__ void qkt_pre8a(QKRing8& R, const int (&ad)[2]) { QK8_RD(R, 0, 0); }
template <int KOFF>
__device__ __forceinline__ void qkt_pre8b(QKRing8& R, const int (&ad)[2]) { QK8_RD(R, 1, 1); }
template <int KOFF>
__device__ __forceinline__ void qkt_pre8(QKRing8& R, const int (&ad)[2]) { qkt_pre8a<KOFF>(R, ad); qkt_pre8b<KOFF>(R, ad); }
template <int KOFF>
__device__ __forceinline__ void qkt_main8(f32x16& p0, f32x16& p1, QKRing8& R, const int (&ad)[2], const v8i_t* q, const f32x16* cin) {
    p0 = *cin; p1 = *cin;
    LDS_TIE2(6, R.fa[0][0], R.fa[0][1]); p0 = MFMA_MX(cat8(R.fa[0][0], R.fa[0][1]), q[0], p0);
    LDS_TIE2(4, R.fb[0][0], R.fb[0][1]); p1 = MFMA_MX(cat8(R.fb[0][0], R.fb[0][1]), q[0], p1);
    QK8_RD(R, 0, 2);
    LDS_TIE2(6, R.fa[1][0], R.fa[1][1]); p0 = MFMA_MX(cat8(R.fa[1][0], R.fa[1][1]), q[1], p0);
    LDS_TIE2(4, R.fb[1][0], R.fb[1][1]); p1 = MFMA_MX(cat8(R.fb[1][0], R.fb[1][1]), q[1], p1);
    LDS_TIE2(2, R.fa[0][0], R.fa[0][1]); p0 = MFMA_MX(cat8(R.fa[0][0], R.fa[0][1]), q[2], p0);
    LDS_TIE2(0, R.fb[0][0], R.fb[0][1]); p1 = MFMA_MX(cat8(R.fb[0][0], R.fb[0][1]), q[2], p1);
}
#undef QK8_RD
template <int KPRE, typename RING, int NAD>
__device__ __forceinline__ void pv_tile_k(f32x16* o, int vb, bf16x8 pa0, bf16x8 pa1, bf16x8 pa2, bf16x8 pa3, RING& KR, const int (&ad)[NAD]) {
#define ATT_TRRD(dst, off) asm volatile("ds_read_b64_tr_b16 %0, %1 offset:%2" : "=&v"(dst) : "v"(vb), "i"(off) : "memory")
    s16x4 l[8], h[8];
#define PV_RD(j_) do { constexpr int jr = (j_); ATT_TRRD(l[jr & 7], v_rd_off(jr & 3, jr >> 2, 0)); ATT_TRRD(h[jr & 7], v_rd_off(jr & 3, jr >> 2, 1)); } while (0)
#define PV_STEP(j_, PA_) do { constexpr int j = (j_); if constexpr (j + 6 < 16) PV_RD(j + 6); \
        if constexpr (KPRE >= 0 && NAD == 4 && j == 12) qkt_pre<(KPRE >= 0 ? KPRE : 0)>(KR, ad); \
        if constexpr (KPRE >= 0 && NAD == 2 && j == 13) qkt_pre8<(KPRE >= 0 ? KPRE : 0)>(KR, ad);        \
        constexpr int n = 2 * ((15 - j) < 6 ? (15 - j) : 6) + ((KPRE >= 0 && NAD == 4 && j >= 12) ? 6 : 0) + ((KPRE >= 0 && NAD == 2 && j >= 13) ? 8 : 0); LDS_TIE2(n, l[j & 7], h[j & 7]); \
        o[j & 3] = MFMA32(PA_, ((bf16x8){l[j & 7][0], l[j & 7][1], l[j & 7][2], l[j & 7][3], h[j & 7][0], h[j & 7][1], h[j & 7][2], h[j & 7][3]}), o[j & 3]); } while (0)
    PV_RD(0); PV_RD(1); PV_RD(2); PV_RD(3); PV_RD(4); PV_RD(5);
    PV_STEP(0, pa0); PV_STEP(1, pa0); PV_STEP(2, pa0); PV_STEP(3, pa0); PV_STEP(4, pa1); PV_STEP(5, pa1); PV_STEP(6, pa1); PV_STEP(7, pa1);
    PV_STEP(8, pa2); PV_STEP(9, pa2); PV_STEP(10, pa2); PV_STEP(11, pa2); PV_STEP(12, pa3); PV_STEP(13, pa3); PV_STEP(14, pa3); PV_STEP(15, pa3);
#undef PV_STEP
#undef PV_RD
#undef ATT_TRRD
}
__device__ __forceinline__ void pv_tile(f32x16* o, int vb, bf16x8 pa0, bf16x8 pa1, bf16x8 pa2, bf16x8 pa3) { QKRing dummy; const int ad0[4] = {0, 0, 0, 0}; pv_tile_k<-1, QKRing, 4>(o, vb, pa0, pa1, pa2, pa3, dummy, ad0); }
template <int KPRE>
__device__ __forceinline__ void pv8_tile_k(f32x16* o, int vb, v8i_t pa, QKRing8& KR, const int (&ad)[2]) {
#define ATT_TRRD(dst, off) asm volatile("ds_read_b64_tr_b16 %0, %1 offset:%2" : "=&v"(dst) : "v"(vb), "i"(off) : "memory")
    u32x2 f[2][4];
#define PV8_RD(d0_) do { constexpr int dr = (d0_); ATT_TRRD(f[dr & 1][0], v_rd_off(dr, 0, 0)); ATT_TRRD(f[dr & 1][1], v_rd_off(dr, 0, 1)); ATT_TRRD(f[dr & 1][2], v_rd_off(dr, 1, 0)); ATT_TRRD(f[dr & 1][3], v_rd_off(dr, 1, 1)); } while (0)
#define PV8_MM(d0_, n_) do { constexpr int dm = (d0_); asm volatile("s_waitcnt lgkmcnt(%4)" : "+v"(f[dm & 1][0]), "+v"(f[dm & 1][1]), "+v"(f[dm & 1][2]), "+v"(f[dm & 1][3]) : "n"(n_)); \
        const v8i_t vb_ = {(int)f[dm & 1][0][0], (int)f[dm & 1][0][1], (int)f[dm & 1][1][0], (int)f[dm & 1][1][1], (int)f[dm & 1][2][0], (int)f[dm & 1][2][1], (int)f[dm & 1][3][0], (int)f[dm & 1][3][1]}; \
        o[dm] = MFMA_MX(pa, vb_, o[dm]); } while (0)
    PV8_RD(0); PV8_RD(1);
    PV8_MM(0, 4); PV8_RD(2);
    PV8_MM(1, 4); PV8_RD(3);
    if constexpr (KPRE >= 0) { qkt_pre8a<(KPRE >= 0 ? KPRE : 0)>(KR, ad); PV8_MM(2, 8); qkt_pre8b<(KPRE >= 0 ? KPRE : 0)>(KR, ad); PV8_MM(3, 8); }
    else { PV8_MM(2, 4); PV8_MM(3, 0); }
#undef PV8_MM
#undef PV8_RD
#undef ATT_TRRD
}
struct AttBlk { const unsigned char* Qp; const unsigned char* Kn; const unsigned char* Kr; const unsigned char* Vp; bf16_t* Op; const bf16_t* Zp; int P0; };
struct AttSeam { v8i_t qr[3]; int kb0, vs0; };
#define ATT_TILE0_DMA(L_, Kn_, Kr_, Vp_, kbase_, vbase_, wid_, lane_) do { \
        const int krow_ = 16 * ((wid_) & 3) + ((lane_) >> 2), kc_ = 16 * (((lane_) & 3) ^ ((krow_ >> 2) & 3)), slot_ = (lane_) & 31; \
        const int st0_ = 2 * (wid_) + ((lane_) >> 5), kk0_ = (st0_ >> 2) * 8 + (slot_ >> 2), c20_ = (st0_ & 3) * 32 + (slot_ & 3) * 8; \
        __builtin_amdgcn_global_load_lds((const unsigned*)((Kn_) + krow_ * MAIN_W + 64 * ((wid_) >> 2) + kc_), (LAS unsigned*)((L_) + (kbase_) + ((wid_) >> 2) * KSUB + ((wid_) & 3) * 1024), 16, 0, 0); \
        if ((wid_) < 4) __builtin_amdgcn_global_load_lds((const unsigned*)((Kr_) + krow_ * 64 + kc_), (LAS unsigned*)((L_) + (kbase_) + 2 * KSUB + (wid_) * 1024), 16, 0, 0); \
        __builtin_amdgcn_global_load_lds((const unsigned*)((Vp_) + kk0_ * (2 * MAIN_W) + c20_ * 2), (LAS unsigned*)((L_) + (vbase_) + (wid_) * 1024), 16, 0, 0); } while (0)
__device__ __forceinline__ void attn_prime(LAS unsigned char* L, const AttBlk& B, AttSeam& S) {
    const int tid = opaque_tid(), wid = __builtin_amdgcn_readfirstlane(tid >> 6), lane = tid & 63, r32 = lane & 31, hi = lane >> 5;
    ATT_TILE0_DMA(L, B.Kn, B.Kr, B.Vp, A_K, A_V, wid, lane);
#pragma unroll
    for (int i = 0; i < 3; ++i) { const unsigned char* qp_ = B.Qp + (size_t)(wid * 32 + r32) * NQ + 64 * i + 16 * hi; S.qr[i] = cat8(*(const u32x4*)qp_, *(const u32x4*)(qp_ + 32)); }
    S.kb0 = 0; S.vs0 = 0;
    asm volatile("s_waitcnt vmcnt(0)" ::: "memory"); __syncthreads();
}
template <int VAR>
__device__ __forceinline__ void attn_block(LAS unsigned char* L, const AttBlk& B, const AttBlk& NX, bool has_next, AttSeam& S) {
    const unsigned char* __restrict__ Kn = B.Kn; const unsigned char* __restrict__ Kr = B.Kr; const unsigned char* __restrict__ Vp = B.Vp; bf16_t* __restrict__ Op = B.Op; const bf16_t* __restrict__ Zp = B.Zp; const int P0 = B.P0;
    const int vs0 = S.vs0;
    v8i_t (&qr)[3] = S.qr;
    const int tid = opaque_tid(), wid = __builtin_amdgcn_readfirstlane(tid >> 6), lane = tid & 63, r32 = lane & 31, hi = lane >> 5;
    const bool h1 = wid < 4;
    const int NT = (P0 + 256) / 64;
    const int qlo = P0 + wid * 32, qm = qlo + r32 - 4 * hi;
    LAS float* wsl = (LAS float*)(L + A_WS) + wid * 64;
    unsigned offKn, offKr, offV0, offV1;
    { const int krow = 16 * (wid & 3) + (lane >> 2), kc = 16 * ((lane & 3) ^ ((krow >> 2) & 3)); offKn = (unsigned)(krow * MAIN_W + kc); offKr = (unsigned)(krow * 64 + kc);
      const int slot = lane & 31;
      { const int st = 2 * (wid & 3) + (lane >> 5), kk = (st >> 2) * 8 + (slot >> 2), c2 = (st & 3) * 32 + (slot & 3) * 8; offV0 = (unsigned)(kk * (2 * MAIN_W) + c2 * 2); }
      { const int st = 2 * ((wid & 3) + 4) + (lane >> 5), kk = (st >> 2) * 8 + (slot >> 2), c2 = (st & 3) * 32 + (slot & 3) * 8; offV1 = (unsigned)(kk * (2 * MAIN_W) + c2 * 2); } }
#define ATT_DMA(gp, ldsoff) __builtin_amdgcn_global_load_lds((const unsigned*)(gp), (LAS unsigned*)(L + (ldsoff)), 16, 0, 0)
#define ATT_DMA_TILE10(t, kbuf, vbuf) do { const unsigned char* kn_ = Kn + (size_t)(t) * 64 * MAIN_W; const unsigned char* kr_ = Kr + (size_t)(t) * 64 * 64; const unsigned char* vp_ = Vp + (size_t)(t) * 64 * MAIN_W; \
        const int kd_ = A_K + (kbuf) * SHM_K + (wid & 3) * 1024, vd_ = A_V + (vbuf) * SHM_V + (wid & 3) * 1024; \
        ATT_DMA(kn_ + offKn, kd_); ATT_DMA(kn_ + offKn + 64, kd_ + KSUB); ATT_DMA(kr_ + offKr, kd_ + 2 * KSUB); ATT_DMA(vp_ + offV0, vd_); ATT_DMA(vp_ + offV1, vd_ + 4096); } while (0)
#define ATT_VMW() asm volatile("s_waitcnt vmcnt(0)" ::: "memory")
#define ATT_VMW2() asm volatile("s_waitcnt vmcnt(2)" ::: "memory")
#define ATT_BAR() do { SBAR(); __builtin_amdgcn_s_barrier(); SBAR(); } while (0)
#define ATT_PIN_M() asm volatile("" : "+v"(p0), "+v"(p1), "+v"(o[0]), "+v"(o[1]), "+v"(o[2]), "+v"(o[3]))
#define ATT_PIN_V() asm volatile("" : "+v"(pa), "+v"(l_reg), "+v"(negm))
    int kb4[2];
#pragma unroll
    for (int j = 0; j < 2; ++j) kb4[j] = (int)(uintptr_t)(L + A_K) + r32 * 64 + 16 * ((2 * j + hi) ^ ((r32 >> 2) & 3));
    const int vb0 = (int)(uintptr_t)(L + A_V) + v_rd_base(lane);
    float m_reg = 0.f, l_reg = 0.f;
    f32x16 o[4], negm;
#pragma unroll
    for (int e = 0; e < 16; ++e) negm[e] = 0.f;
#pragma unroll
    for (int d = 0; d < 4; ++d)
#pragma unroll
        for (int e = 0; e < 16; ++e) o[d][e] = 0.f;
    f32x16 p0, p1; float al = 1.f; v8i_t pa; QKRing8 KR;
#define ATT_MASKT(t) do { const int kb_ = (t) * 64; if (kb_ + 63 > qlo) mask_tile(p0, p1, qm - kb_); } while (0)
#define ATT_RESC(a) do { if (__any((a) < 1.f)) { if (hi == 0) wsl[32 + r32] = (a); asm volatile("s_waitcnt lgkmcnt(0)" ::: "memory"); \
        _Pragma("unroll") for (int d_ = 0; d_ < 4; ++d_) _Pragma("unroll") for (int r = 0; r < 16; ++r) o[d_][r] *= wsl[32 + crow(r, hi)]; } } while (0)
#define ATT_SOFTMAX(t) do { ATT_MASKT(t); partialSM_rel8<false>(p0, p1, m_reg, al, negm); ATT_RESC(al); finishSM_exp(p0, p1, al, l_reg); pa = packP8(p0, p1); } while (0)
    int vprev = vs0;
    if (h1) { ATT_DMA_TILE10(1, 1, (vs0 + 1) % 3); ATT_BAR(); }
    qkt_pre8<0>(KR, kb4); qkt_main8<0>(p0, p1, KR, kb4, qr, &negm); ATT_PIN_M(); if (h1) ATT_VMW2(); ATT_BAR();
    if (h1) ATT_DMA_TILE10(2, 0, (vs0 + 2) % 3);
    ATT_MASKT(0); partialSM_rel8<true>(p0, p1, m_reg, al, negm); finishSM_exp(p0, p1, al, l_reg); pa = packP8(p0, p1); ATT_PIN_V(); ATT_BAR();
#define ATT_STEP(t, PAR) do { \
        qkt_pre8<(PAR) * SHM_K>(KR, kb4); qkt_main8<(PAR) * SHM_K>(p0, p1, KR, kb4, qr, &negm); pv8_tile_k<-1>(o, vb0 + vprev * SHM_V, pa, KR, kb4); ATT_PIN_M(); if (h1) { if ((t) + 1 < NT) ATT_VMW2(); else ATT_VMW(); } ATT_BAR(); \
        if (h1 && (t) + 2 < NT) ATT_DMA_TILE10((t) + 2, (PAR), vprev); \
        ATT_SOFTMAX(t); ATT_PIN_V(); ATT_BAR(); \
        vprev = (vprev == 2) ? 0 : vprev + 1; } while (0)
    int t = 1;
    for (; t + 1 < NT; t += 2) { ATT_STEP(t, 1); ATT_STEP(t + 1, 0); }
    ATT_STEP(t, 1);
    if (!h1) ATT_BAR();
    if (has_next) {
        { int ln_ = lane; asm volatile("" : "+v"(ln_));
          ATT_TILE0_DMA(L, NX.Kn, NX.Kr, NX.Vp, A_K, A_V + ((vs0 + NT) % 3) * SHM_V, wid, ln_); }
#pragma unroll
        for (int i = 0; i < 3; ++i) { const unsigned char* qp_ = NX.Qp + (size_t)(wid * 32 + r32) * NQ + 64 * i + 16 * hi; qr[i] = cat8(*(const u32x4*)qp_, *(const u32x4*)(qp_ + 32)); }
        S.kb0 = 0; S.vs0 = (vs0 + NT) % 3;
    }
    SBAR();
    pv8_tile_k<-1>(o, vb0 + vprev * SHM_V, pa, KR, kb4);
    {
        LAS unsigned char* stg = L + A_OST + wid * 4096;
        u32x4 zw[8];
#pragma unroll
        for (int hf = 0; hf < 2; ++hf)
#pragma unroll
            for (int i = 0; i < 4; ++i) zw[hf * 4 + i] = *(const u32x4*)(Zp + (size_t)(wid * 32 + i * 8 + (lane >> 3)) * NBP + hf * 64 + (lane & 7) * 8);
        if (hi == 0) wsl[r32] = l_reg; asm volatile("s_waitcnt lgkmcnt(0)" ::: "memory");
        float rl[16];
#pragma unroll
        for (int r = 0; r < 16; ++r) rl[r] = __builtin_amdgcn_rcpf(wsl[crow(r, hi)]);
#pragma unroll
        for (int hf = 0; hf < 2; ++hf) {
#pragma unroll
            for (int r = 0; r < 16; ++r)
#pragma unroll
                for (int d1 = 0; d1 < 2; ++d1) *(LAS bf16_t*)(stg + crow(r, hi) * 128 + (d1 * 32 + r32) * 2) = (bf16_t)(cvtpk(o[hf * 2 + d1][r] * rl[r], 0.f) & 0xffffu);
            asm volatile("s_waitcnt lgkmcnt(0)" ::: "memory"); __builtin_amdgcn_wave_barrier();
#pragma unroll
            for (int i = 0; i < 4; ++i) { const int row = i * 8 + (lane >> 3), ch = lane & 7;
                const u32x4 ov = *(const LAS u32x4*)(stg + row * 128 + ch * 16); const u32x4 z4 = zw[hf * 4 + i]; u32x4 w4;
#pragma unroll
                for (int e = 0; e < 4; ++e) w4[e] = cvtpk(bf2f(ov[e] & 0xffffu) * siluf_(bf2f(z4[e] & 0xffffu)), bf2f(ov[e] >> 16) * siluf_(bf2f(z4[e] >> 16)));
                *(u32x4*)(Op + (size_t)(wid * 32 + row) * D_MODEL + hf * 64 + ch * 8) = w4; }
            asm volatile("s_waitcnt lgkmcnt(0)" ::: "memory"); __builtin_amdgcn_wave_barrier();
        }
    }
    asm volatile("s_waitcnt vmcnt(0)" ::: "memory"); __syncthreads();
#undef ATT_DMA
#undef ATT_DMA_TILE
#undef ATT_VMW
#undef ATT_VMW2
#undef ATT_BAR
#undef ATT_PIN_M
#undef ATT_PIN_V
#undef ATT_MASKT
#undef ATT_RESC
#undef ATT_STEP
#undef ATT_SOFTMAX
#undef ATT_DMA_TILE10
}

constexpr int M_K = 0, M_V = 65536, M_WS = 131072, M_BYTES = M_WS + 2048;
__device__ __forceinline__ void memattn_load(LAS unsigned char* L, const bf16_t* __restrict__ MK, const bf16_t* __restrict__ MV) {
    const int tid = opaque_tid(), wid = __builtin_amdgcn_readfirstlane(tid >> 6), lane = tid & 63;
    const int row = 8 * wid + (lane >> 3), c = (lane & 7) ^ ((row >> 1) & 7), slot = lane & 31;
    const unsigned offK = (unsigned)(row * 2048 + c * 8);
    unsigned offV0, offV1;
    { const int st = 2 * wid + (lane >> 5), kk = (st >> 2) * 8 + (slot >> 2), key = (kk & ~0xC) | ((kk & 4) << 1) | ((kk & 8) >> 1), c2 = (st & 3) * 32 + (slot & 3) * 8; offV0 = (unsigned)(key * 2048 + c2); }
    { const int st = 2 * (wid + 8) + (lane >> 5), kk = (st >> 2) * 8 + (slot >> 2), key = (kk & ~0xC) | ((kk & 4) << 1) | ((kk & 8) >> 1), c2 = (st & 3) * 32 + (slot & 3) * 8; offV1 = (unsigned)(key * 2048 + c2); }
#pragma unroll
    for (int j = 0; j < 4; ++j) {
        const bf16_t* mk = MK + (size_t)j * 64 * 2048; const bf16_t* mv = MV + (size_t)j * 64 * 2048;
        __builtin_amdgcn_global_load_lds((const unsigned*)(mk + offK), (LAS unsigned*)(L + M_K + j * 16384 + wid * 1024), 16, 0, 0);
        __builtin_amdgcn_global_load_lds((const unsigned*)(mk + offK + 64), (LAS unsigned*)(L + M_K + j * 16384 + KSUB + wid * 1024), 16, 0, 0);
        __builtin_amdgcn_global_load_lds((const unsigned*)(mv + offV0), (LAS unsigned*)(L + M_V + j * 16384 + wid * 1024), 16, 0, 0);
        __builtin_amdgcn_global_load_lds((const unsigned*)(mv + offV1), (LAS unsigned*)(L + M_V + j * 16384 + 8192 + wid * 1024), 16, 0, 0);
    }
    asm volatile("s_waitcnt vmcnt(0)" ::: "memory"); __syncthreads();
}
__device__ __forceinline__ void memattn_tile(LAS unsigned char* L, const bf16_t* __restrict__ Qp, int ldq, bf16_t* __restrict__ Op, const bf16_t* __restrict__ Zp) {
    const int tid = opaque_tid(), wid = __builtin_amdgcn_readfirstlane(tid >> 6), lane = tid & 63, r32 = lane & 31, hi = lane >> 5;
    LAS float* wsl = (LAS float*)(L + M_WS) + wid * 64;
    bf16x8 qr[8];
#pragma unroll
    for (int d0 = 0; d0 < 8; ++d0) qr[d0] = *(const bf16x8*)(Qp + (size_t)(wid * 32 + r32) * ldq + d0 * 16 + hi * 8);
    int kb4[4];
#pragma unroll
    for (int dd = 0; dd < 4; ++dd) kb4[dd] = (int)(uintptr_t)(L + M_K) + r32 * 128 + 16 * ((2 * dd + hi) ^ ((r32 >> 1) & 7));
    const int vb0 = (int)(uintptr_t)(L + M_V) + v_rd_base(lane);
    float m_reg = -1e30f, l_reg = 0.f, alA = 1.f, alB = 1.f;
    f32x16 o[4];
#pragma unroll
    for (int d = 0; d < 4; ++d)
#pragma unroll
        for (int e = 0; e < 16; ++e) o[d][e] = 0.f;
    f32x16 pA0, pA1, pB0, pB1; bf16x8 pa0, pa1, pa2, pa3;
#define MEM_RESC(a) do { if (__any((a) < 1.f)) { if (hi == 0) wsl[32 + r32] = (a); asm volatile("s_waitcnt lgkmcnt(0)" ::: "memory"); \
        _Pragma("unroll") for (int d_ = 0; d_ < 4; ++d_) _Pragma("unroll") for (int r = 0; r < 16; ++r) o[d_][r] *= wsl[32 + crow(r, hi)]; } } while (0)
#define MEM_STEP(PX0, PX1, alX, PY0, PY1, alY, t) do { SBAR(); qkt<2, (t) * 16384>(PX0, PX1, kb4, qr); finishSM(PY0, PY1, alY, l_reg, pa0, pa1, pa2, pa3); SBAR(); \
        pv_tile(o, vb0 + ((t) - 1) * 16384, pa0, pa1, pa2, pa3); partialSM(PX0, PX1, m_reg, alX); MEM_RESC(alX); } while (0)
    qkt<2, 0>(pA0, pA1, kb4, qr); partialSM(pA0, pA1, m_reg, alA);
    MEM_STEP(pB0, pB1, alB, pA0, pA1, alA, 1); MEM_STEP(pA0, pA1, alA, pB0, pB1, alB, 2); MEM_STEP(pB0, pB1, alB, pA0, pA1, alA, 3);
    unsigned zz[16][4];
#pragma unroll
    for (int r = 0; r < 16; ++r)
#pragma unroll
        for (int d0 = 0; d0 < 4; ++d0) zz[r][d0] = Zp[(size_t)(wid * 32 + crow(r, hi)) * ldq + d0 * 32 + r32];
    finishSM(pB0, pB1, alB, l_reg, pa0, pa1, pa2, pa3); SBAR(); pv_tile(o, vb0 + 3 * 16384, pa0, pa1, pa2, pa3);
    if (hi == 0) wsl[r32] = l_reg; asm volatile("s_waitcnt lgkmcnt(0)" ::: "memory");
    unsigned pk[16][4];
#pragma unroll
    for (int r = 0; r < 16; ++r) { const float rl = __builtin_amdgcn_rcpf(wsl[crow(r, hi)]);
#pragma unroll
        for (int d0 = 0; d0 < 4; ++d0) { const float v = o[d0][r] * rl * siluf_(bf2f(zz[r][d0]));
            const float vn = __int_as_float(__builtin_amdgcn_update_dpp(0, __float_as_int(v), 0xB1, 0xF, 0xF, true));
            pk[r][d0] = cvtpk(v, vn); } }
    if ((r32 & 1) == 0) {
#pragma unroll
        for (int r = 0; r < 16; ++r)
#pragma unroll
            for (int d0 = 0; d0 < 4; ++d0) *(unsigned*)(Op + (size_t)(wid * 32 + crow(r, hi)) * D_MODEL + d0 * 32 + r32) = pk[r][d0];
    }
    asm volatile("s_waitcnt lgkmcnt(0)" ::: "memory");
#undef MEM_RESC
#undef MEM_STEP
}
__device__ __forceinline__ void memattn_phase(LAS unsigned char* L, const bf16_t* __restrict__ Hq, int ldq, int qoff, int zoff, const bf16_t* __restrict__ MEMKV, int layer, bf16_t* __restrict__ CAT, int u0, int u1) {
    int loaded = -1;
    for (int u = u0; u < 512 && u < u1; ++u) {
        const int bhd = u >> 6, tt = u & 63, b = bhd >> 2, hd = bhd & 3;
        if (bhd != loaded) { if (loaded >= 0) __syncthreads();
            const bf16_t* MK = MEMKV + (size_t)b * 256 * 2048 + layer * 1024 + hd * 128; memattn_load(L, MK, MK + 512); loaded = bhd; }
        const size_t tok0 = (size_t)b * SEQ + (size_t)tt * 256;
        memattn_tile(L, Hq + tok0 * ldq + qoff + hd * 128, ldq, CAT + tok0 * D_MODEL + MAIN_W + hd * 128, Hq + tok0 * ldq + zoff + hd * 128);
    }
    __syncthreads();
}
#undef SBAR
}


#define XB_TMO      128
#define XB_XCNT(j)  (256  + 64 * (j))
#define XB_XSUB(j)  (1280 + 64 * (j))
#define XB_XGEN(j)  (2304 + 64 * (j))
#define XB_TOP      3328
#define XB_TOPGEN   3392
#define XCD_BAR_WORDS 3456
#define XB_SPIN_CAP (1u << 20)
__device__ __forceinline__ unsigned xb_ld(unsigned* p)              { return __hip_atomic_load(p, __ATOMIC_RELAXED, __HIP_MEMORY_SCOPE_AGENT); }
__device__ __forceinline__ unsigned xb_add(unsigned* p, unsigned v) { return __hip_atomic_fetch_add(p, v, __ATOMIC_RELAXED, __HIP_MEMORY_SCOPE_AGENT); }
__device__ __forceinline__ unsigned xb_xcc_id() { return (unsigned)__builtin_amdgcn_s_getreg((3 << 11) | 20) & 0xFu; }
#define XB_SPIN(cond, bar) do { unsigned _sp = 0; while (cond) { __builtin_amdgcn_s_sleep(1); \
    if ((++_sp & 255u) == 0u) { if (xb_ld(&(bar)[XB_TMO])) break; if (_sp > XB_SPIN_CAP) { atomicAdd(&(bar)[XB_TMO], 1u); break; } } } } while (0)
struct XcdBarrier { unsigned* bar; unsigned x; volatile LAS unsigned* st; };
__device__ __forceinline__ XcdBarrier xcd_barrier_post(unsigned* bar, volatile LAS unsigned* st) {
    XcdBarrier b; b.bar = bar; b.x = xb_xcc_id(); b.st = st;
    if (threadIdx.x == 0) (void)xb_add(&bar[XB_XCNT(b.x)], 1u);
    return b;
}
__device__ __forceinline__ void xcd_barrier_complete(unsigned* bar, unsigned x, unsigned& nloc, unsigned& nx) {
    const unsigned G = gridDim.x * gridDim.y * gridDim.z;
    unsigned sum, cnt, mine, sp = 0u;
    for (;;) {
        sum = 0u; cnt = 0u; mine = 0u;
#pragma unroll
        for (unsigned j = 0; j < 16; ++j) { const unsigned c = xb_ld(&bar[XB_XCNT(j)]); sum += c; cnt += (c > 0u) ? 1u : 0u; mine = (j == x) ? c : mine; }
        if (sum == G) break;
        __builtin_amdgcn_s_sleep(1);
        if ((++sp & 255u) == 0u) { if (xb_ld(&bar[XB_TMO])) break; if (sp > XB_SPIN_CAP) { atomicAdd(&bar[XB_TMO], 1u); break; } }
    }
    nloc = mine > 0u ? mine : 1u; nx = cnt > 0u ? cnt : 1u;
}
__device__ __forceinline__ void xcd_barrier(const XcdBarrier& b) {
    asm volatile("s_waitcnt vmcnt(0)" ::: "memory");
    __syncthreads();
    if (threadIdx.x == 0) {
        unsigned* bar = b.bar;
        __builtin_amdgcn_s_waitcnt(0);
        unsigned nloc = b.st[0], nx = b.st[1];
        if (nloc == 0u) { xcd_barrier_complete(bar, b.x, nloc, nx); b.st[0] = nloc; b.st[1] = nx; }
        const unsigned old = xb_add(&bar[XB_XSUB(b.x)], 1u);
        const unsigned gen = old / nloc;
        if (old + 1u == (gen + 1u) * nloc) {
            __builtin_amdgcn_fence(__ATOMIC_RELEASE, "agent");
            asm volatile("s_waitcnt vmcnt(0)" ::: "memory");
            const unsigned og = xb_add(&bar[XB_TOP], 1u);
            const unsigned tg = og / nx;
            if (og + 1u == (tg + 1u) * nx) xb_add(&bar[XB_TOPGEN], 1u);
            else XB_SPIN(xb_ld(&bar[XB_TOPGEN]) == tg, bar);
            __builtin_amdgcn_fence(__ATOMIC_ACQUIRE, "agent");
            xb_add(&bar[XB_XGEN(b.x)], 1u);
            asm volatile("s_waitcnt vmcnt(0)" ::: "memory");
        } else {
            XB_SPIN(xb_ld(&bar[XB_XGEN(b.x)]) == gen, bar);
            __builtin_amdgcn_fence(__ATOMIC_ACQUIRE, "agent");
            asm volatile("s_waitcnt vmcnt(0)" ::: "memory");
        }
    }
    __syncthreads();
}

struct Params { const void* in[26]; float* out; unsigned char* ws; };
#ifndef DUP_PHASE
#define DUP_PHASE -1
#endif
#define REPS(k) for (int rep_ = 0; rep_ < ((DUP_PHASE == (k)) ? 2 : 1); ++rep_, (void)((DUP_PHASE == (k)) && rep_ == 1 ? (xcd_barrier(gbar), 0) : 0))

__global__ void __launch_bounds__(NT_, 2) mega(Params P) {
    extern __shared__ __attribute__((aligned(16))) unsigned char lds[];
    cg::grid_group grid = cg::this_grid();
    LAS unsigned char* L = (LAS unsigned char*)lds;
    volatile LAS unsigned* bst = (volatile LAS unsigned*)(L + LDS_BYTES - 64);
    if (threadIdx.x < 2) bst[threadIdx.x] = 0u;
    __syncthreads();
    XcdBarrier gbar = xcd_barrier_post((unsigned*)P.ws + 4096, bst);
#define GRID_BAR() xcd_barrier(gbar)
    const int nb = gridDim.x, bid = blockIdx.x, ngw = nb * 8;
    const size_t ngt = (size_t)nb * NT_;
#define IDS() const int tid = opaque_tid(), lane = tid & 63, wave = __builtin_amdgcn_readfirstlane(tid >> 6), gw = bid * 8 + wave; const size_t gt = (size_t)bid * NT_ + tid; (void)lane; (void)gw; (void)gt
    const float* x = (const float*)P.in[0]; const float* mem = (const float*)P.in[1]; const int* positions = (const int*)P.in[2];
    const float* w_in_a = (const float*)P.in[3]; const float* lam_re = (const float*)P.in[4]; const float* lam_im = (const float*)P.in[5]; const float* log_dt = (const float*)P.in[6];
    const float* b_re = (const float*)P.in[7]; const float* b_im = (const float*)P.in[8]; const float* c_re = (const float*)P.in[9]; const float* c_im = (const float*)P.in[10];
    const float* d_skip = (const float*)P.in[11]; const float* w_glu = (const float*)P.in[12]; const float* b_glu = (const float*)P.in[13];
    const float* w_in_b = (const float*)P.in[14]; const float* q_norm_g = (const float*)P.in[15]; const float* w_uq = (const float*)P.in[16]; const float* w_dkv = (const float*)P.in[17];
    const float* kv_norm_g = (const float*)P.in[18]; const float* w_kr = (const float*)P.in[19]; const float* w_uk = (const float*)P.in[20]; const float* w_uv = (const float*)P.in[21];
    const float* w_mem_kv = (const float*)P.in[22]; const float* w_out = (const float*)P.in[23]; const float* ln_g = (const float*)P.in[24]; const float* ln_b = (const float*)P.in[25];
    float* out = P.out; unsigned char* ws = P.ws; unsigned* CTL = (unsigned*)ws;
    bf16_t* WA = (bf16_t*)(ws + WS_WA); bf16_t* WGLU = (bf16_t*)(ws + WS_WGLU); bf16_t* WOUT = (bf16_t*)(ws + WS_WOUT); bf16_t* WB = (bf16_t*)(ws + WS_WB);
    bf16_t* WUKV = (bf16_t*)(ws + WS_WUKV); bf16_t* WUQ = (bf16_t*)(ws + WS_WUQ); bf16_t* WMEM = (bf16_t*)(ws + WS_WMEM); bf16_t* MEMB = (bf16_t*)(ws + WS_MEMB);
    bf16_t* MEMKV = (bf16_t*)(ws + WS_MEMKV); float* CS = (float*)(ws + WS_ROPE); float* SN = CS + (size_t)T * 32; float* RQ = (float*)(ws + WS_RQ); float* RKV = (float*)(ws + WS_RKV);
    bf16_t* XB = (bf16_t*)(ws + WS_XB); bf16_t* H = (bf16_t*)(ws + WS_H); bf16_t* G = (bf16_t*)(ws + WS_G); bf16_t* Qb = (bf16_t*)(ws + WS_G); bf16_t* CAT = (bf16_t*)(ws + WS_CAT); bf16_t* KV = (bf16_t*)(ws + WS_KV);
    bf16_t* GZ = (bf16_t*)(ws + WS_KV);
    bf16_t* Y0 = (bf16_t*)(ws + WS_H);
    bf16_t* Y1 = (bf16_t*)(ws + WS_G); bf16_t* KRb = (bf16_t*)(ws + WS_KR);
    unsigned char* Q8 = ws + WS_G; unsigned char* V8P = ws + WS_KV; unsigned char* KN8 = ws + WS_KV + (size_t)T * MAIN_W * 2; unsigned char* KR8 = ws + WS_KR;

    {
        IDS();
        int base = 0;
        LAS float* scr = (LAS float*)(L + wave * 8448);
#define WTJOB(W_, K_, Nsrc_, Wt_, roff_, nrows_, ks_, perm_) do { const int nit_ = ((nrows_) / 32) * ((K_) / 64); \
            for (int it_ = (gw - base % ngw + ngw) % ngw; it_ < nit_; it_ += ngw) wt_item_wave((W_), (K_), (Nsrc_), (Wt_), (roff_), (ks_), (perm_), it_, scr, lane); \
            base += nit_; } while (0)
        WTJOB(w_in_a, 2048, 4096, WA, 0, 4096, nullptr, 0);
        WTJOB(w_glu, 1536, 1536, WGLU, 0, 1536, nullptr, 0);
        WTJOB(w_out, 2048, 2048, WOUT, 0, 2048, nullptr, 0);
        WTJOB(w_out + (size_t)2048 * 2048, 2048, 2048, WOUT + (size_t)2048 * 2048, 0, 2048, nullptr, 0);
        WTJOB(w_in_b, 2048, 3072, WB, 0, 3072, nullptr, 0);
        WTJOB(w_dkv, 2048, 512, WB, HB_CKV, 512, nullptr, 0);
        WTJOB(w_kr, 2048, 64, WB, WB_KR, 64, nullptr, 1);
        WTJOB(w_uk, 512, 1536, WUKV, 0, 1536, kv_norm_g, 0);
        WTJOB(w_uv, 512, 1536, WUKV, 1536, 1536, kv_norm_g, 0);
        WTJOB(w_uq, 512, 2304, WUQ, 0, 2304, q_norm_g, 2);
        WTJOB(w_mem_kv, 2048, 1024, WMEM, 0, 1024, nullptr, 0);
        WTJOB(w_mem_kv + (size_t)2048 * 1024, 2048, 1024, WMEM, 1024, 1024, nullptr, 0);
#undef WTJOB
        if (bid == 0 && tid < 256) CTL[tid] = 0u;
        for (size_t i = gt; i < (size_t)T * 32; i += ngt) {
            const int row = (int)(i >> 5), j = (int)(i & 31);
            const double inv = exp2(-(double)j * (13.287712379549449 / 32.0));
            const double turns = (double)positions[row] * inv * 0.15915494309189535;
            const double fr = turns - rint(turns);
            const float a = (float)(fr * 6.283185307179586);
            CS[i] = cosf(a); SN[i] = sinf(a);
        }
        for (size_t i = gt; i < (size_t)T * D_MODEL / 4; i += 4 * ngt) {
            f32x4 v[4];
#pragma unroll
            for (int j = 0; j < 4; ++j) { const size_t ii = i + (size_t)j * ngt; v[j] = (ii < (size_t)T * D_MODEL / 4) ? __builtin_nontemporal_load((const f32x4*)x + ii) : (f32x4){0.f, 0.f, 0.f, 0.f}; }
#pragma unroll
            for (int j = 0; j < 4; ++j) { const size_t ii = i + (size_t)j * ngt; if (ii < (size_t)T * D_MODEL / 4) ((u32x2*)XB)[ii] = (u32x2){cvtpk(v[j][0], v[j][1]), cvtpk(v[j][2], v[j][3])}; }
        }
        for (size_t i = gt; i < (size_t)512 * 2048 / 4; i += ngt) { const f32x4 v = ((const f32x4*)mem)[i]; ((u32x2*)MEMB)[i] = (u32x2){pk2(v[0], v[1]), pk2(v[2], v[3])}; }
    }
    grid.sync();
    REPS(1) {
    for (int u = bid; u < 512; u += nb) skinny_unit<false>(L, MEMB, WMEM, (u >> 5) * 32, (u & 31) * 64, MEMKV, 2048, nullptr, nullptr);
    if (nb == 256) gemm_fast<EpiStore, true>(L, XB, 2048, WA, 2048, T, H_MQ, 2048, EpiStore{H, NA, 0, 0, 1.f});
    else gemm_fast<EpiStore, true>(L, XB, 2048, WA, 2048, T, NA, 2048, EpiStore{H, NA, H_MQ, H_MZ, C2_MEM});
    }
    GRID_BAR();
    REPS(2) {
    {
        IDS();
        const int xcd = bid & 7, slot = bid >> 3;
        if (nb == 256 && slot < 24) s5_unit(L, xcd * 24 + slot, H, lam_re, lam_im, log_dt, b_re, b_im, c_re, c_im, d_skip, G, GZ);
        else if (nb != 256) { for (int u = bid; u < 192; u += nb) s5_unit(L, u, H, lam_re, lam_im, log_dt, b_re, b_im, c_re, c_im, d_skip, G, GZ); }
        if (nb == 256) { if (slot >= 24) gemm_fast<EpiStore, true>(L, XB, 2048, WA + (size_t)H_MQ * 2048, 2048, T, 512, 2048, EpiStore{H + H_MQ, NA, 0, 512, C2_MEM}, 64, xcd * 8 + (slot - 24)); }
        else { const int per = (512 + nb - 1) / nb; att::memattn_phase(L, H, NA, H_MQ, H_MZ, MEMKV, 0, CAT, bid * per, (bid + 1) * per); }
    }
    }
    GRID_BAR();
    if (nb == 256) {
        gemm_fast<EpiStore, true>(L, XB, 2048, WA + (size_t)H_MZ * 2048, 2048, T, 512, 2048, EpiStore{H + H_MZ, NA, 0, 0, 1.f});
        GRID_BAR();
    }
    REPS(3) {
    gemm_fast<EpiGlu, true>(L, G, MAIN_W, WGLU, MAIN_W, T, MAIN_W, MAIN_W, EpiGlu{GZ, b_glu, CAT});
    if (nb == 256) att::memattn_phase(L, H, NA, H_MQ, H_MZ, MEMKV, 0, CAT, 2 * bid, 2 * bid + 2);
    }
    GRID_BAR();
    REPS(4) {
    gemm_fast<EpiStore, true>(L, CAT, D_MODEL, WOUT, D_MODEL, T, D_MODEL, D_MODEL, EpiStore{Y0, D_MODEL, 0, 0, 1.f});
    }
    GRID_BAR();
    REPS(5) { IDS(); for (int row = 2 * gw; row < T; row += 2 * ngw) ln_rows2<false, false>(x, Y0, nullptr, ln_g, ln_b, XB, row, lane); }
    GRID_BAR();
    REPS(6) {
    gemm_fast<EpiStore, true>(L, XB, 2048, WB, 2048, T, NBP, 2048, EpiStore{H, NBP, HB_MQ, HB_MZ, C2_MEM});
    }
    GRID_BAR();
    REPS(7) {
    { IDS();
      for (int u = bid; u < T / 32; u += nb) skinny_unit<true>(L, XB, WB + (size_t)WB_KR * 2048, u * 32, 0, KRb, 64, CS, SN);
      for (int row = gw; row < T; row += ngw) rms_row(H, RQ, RKV, row, lane); }
    }
    GRID_BAR();
    REPS(8) {
    gemm_fast<EpiKV, true>(L, H + HB_CKV, NBP, WUKV, 512, T, NKV, 512, EpiKV{KN8, V8P, RKV});
    gemm_fast<EpiQ, true>(L, H + HB_CQ, NBP, WUQ, 512, T, NQ, 512, EpiQ{Q8, RQ, CS, SN});
    if (nb == 256) { if (bid < 128) att::memattn_phase(L, H, NBP, HB_MQ, HB_MZ, MEMKV, 1, CAT, bid, bid + 1);
        else att::memattn_phase(L, H, NBP, HB_MQ, HB_MZ, MEMKV, 1, CAT, 128 + 3 * (bid - 128), 128 + 3 * (bid - 128) + 3); }
    else { const int per = (512 + nb - 1) / nb; att::memattn_phase(L, H, NBP, HB_MQ, HB_MZ, MEMKV, 1, CAT, bid * per, (bid + 1) * per); }
    }
    GRID_BAR();
#ifndef ATT_PROBE
#define ATT_PROBE 0
#endif
#define ATT_BLK(k_, B_) do { const int it_ = (nb == 256) ? (3 * (bid & 7) + ((k_) >> 1)) * 32 + (bid >> 3) : bid + ((k_) >> 1) * nb; \
        const int bh_ = it_ >> 5, xq_ = it_ & 31, b_ = bh_ / 12, hd_ = bh_ % 12, qb_ = ((k_) & 1) ? xq_ : 63 - xq_;     \
        const size_t tok0_ = (size_t)b_ * SEQ + (size_t)qb_ * 256, key0_ = (size_t)b_ * SEQ; \
        B_.Qp = Q8 + tok0_ * NQ + hd_ * 192; B_.Kn = KN8 + key0_ * MAIN_W + hd_ * 128; B_.Kr = KR8 + key0_ * 64; B_.Vp = V8P + key0_ * MAIN_W + hd_ * 256; \
        B_.Op = CAT + tok0_ * D_MODEL + hd_ * 128; B_.Zp = H + tok0_ * NBP + HB_Z + hd_ * 128; B_.P0 = qb_ * 256; } while (0)
#define ATT_PHASE(VAR_) do { const int nblk_ = 2 * ((24 * 32 - bid + nb - 1) / nb); if (nblk_ > 0) { att::AttBlk cur_, nxt_; att::AttSeam seam_; ATT_BLK(0, cur_); att::attn_prime(L, cur_, seam_); \
            _Pragma("unroll 1") for (int k_ = 0; k_ < nblk_; ++k_) { const bool hn_ = k_ + 1 < nblk_; if (hn_) ATT_BLK(k_ + 1, nxt_); else nxt_ = cur_; \
                att::attn_block<VAR_>(L, cur_, nxt_, hn_, seam_); cur_ = nxt_; } } } while (0)
    if (ATT_PROBE != 0) { ATT_PHASE(ATT_PROBE); GRID_BAR(); }
    REPS(9) { ATT_PHASE(0); }
    GRID_BAR();
    gemm_fast<EpiStore, true>(L, CAT, D_MODEL, WOUT + (size_t)2048 * 2048, D_MODEL, T, D_MODEL, D_MODEL, EpiStore{Y1, D_MODEL, 0, 0, 1.f});
    GRID_BAR();
    { IDS(); for (int row = 2 * gw; row < T; row += 2 * ngw) ln_rows2<true, true>(XB, Y1, out, ln_g + D_MODEL, ln_b + D_MODEL, nullptr, row, lane); }
}
}

extern "C" void kernel_launch(void* const* d_in, const int* in_sizes, int n_in, void* d_out, int out_size, void* d_ws, size_t ws_size, hipStream_t stream) {
    static int grid_blocks = 0;
    if (grid_blocks == 0) {
        if (n_in != 26 || in_sizes[0] != T * D_MODEL || out_size != T * D_MODEL || ws_size < WS_END) {
            fprintf(stderr, "kernel_launch: unexpected shapes (n_in %d, in0 %d, out %d, ws %zu)\n", n_in, n_in > 0 ? in_sizes[0] : -1, out_size, ws_size); grid_blocks = -1; return; }
        int dev = 0, cus = 0, per_cu = 0;
        (void)hipGetDevice(&dev);
        (void)hipDeviceGetAttribute(&cus, hipDeviceAttributeMultiprocessorCount, dev);
        (void)hipFuncSetAttribute((const void*)mega, hipFuncAttributeMaxDynamicSharedMemorySize, LDS_BYTES);
        (void)hipOccupancyMaxActiveBlocksPerMultiprocessor(&per_cu, (const void*)mega, NT_, LDS_BYTES);
        if (per_cu < 1) { fprintf(stderr, "kernel_launch: occupancy query says %d blocks per CU\n", per_cu); per_cu = 1; }
        grid_blocks = cus * per_cu;
        (void)hipGetLastError();
    }
    if (grid_blocks < 0) return;
    (void)hipMemsetAsync((char*)d_ws + 4096 * 4, 0, XCD_BAR_WORDS * 4, stream);
    Params p{};
    for (int i = 0; i < 26; ++i) p.in[i] = d_in[i];
    p.out = (float*)d_out; p.ws = (unsigned char*)d_ws;
    void* args[] = {&p};
    hipError_t e = hipLaunchCooperativeKernel((const void*)mega, dim3(grid_blocks), dim3(NT_), args, LDS_BYTES, stream);
    if (e != hipSuccess) fprintf(stderr, "cooperative launch failed: %s (grid %d)\n", hipGetErrorString(e), grid_blocks);
}
```
